# Optimizing an MI355X kernel written in HIP

```python
import math
import jax, jax.numpy as jnp
from jax import lax
import numpy as np

D_MODEL = 2048
BATCH = 2
SEQ = 8192
DEPTH = 1

CTX_LEN = 256
GRID_W = 64
S5_WIDTH = 1024
S5_GROUP = 16
S5_GROUPS = S5_WIDTH // S5_GROUP
S5_STATE = 64
HY_WIDTH = 1024
HY_BANDS = 16
HY_POS_DIM = 1 + 2 * HY_BANDS
HY_HIDDEN = 64
HY_DECAY_TARGET = 1e-2
HY_FAST_PCT = 0.3
HY_SLOW_PCT = 1.5
SHORT_CONV = 3
D_FF = -(-8 * D_MODEL // (3 * 256)) * 256
IN_COLS = S5_WIDTH + 3 * HY_WIDTH + 2 * D_MODEL
N_ADA = 6
EPS = 1e-6
DT_MIN = 1e-3
DT_MAX = 1e-1

kernel_name = "hybrid_s5_hyena_prefix_dit_block"


def rms_norm(x, g):
    xf = x.astype(jnp.float32)
    y = xf * lax.rsqrt(jnp.mean(xf * xf, axis=-1, keepdims=True) + EPS)
    return (y * g.astype(jnp.float32)).astype(x.dtype)


def modulate(x, g, shift, scale):
    return rms_norm(x, g) * (1.0 + scale[:, None, :]) + shift[:, None, :]


def sincos_2d(n_rows, dim):
    rows = jnp.repeat(jnp.arange(n_rows, dtype=jnp.float32), GRID_W)
    cols = jnp.tile(jnp.arange(GRID_W, dtype=jnp.float32), n_rows)
    quarter = dim // 4
    omega = 10000.0 ** (-jnp.arange(quarter, dtype=jnp.float32) / quarter)
    ar = rows[:, None] * omega
    ac = cols[:, None] * omega
    return jnp.concatenate([jnp.sin(ar), jnp.cos(ar), jnp.sin(ac), jnp.cos(ac)], axis=-1)


def linear_recurrence(e_i, e_j):
    a_i, b_i = e_i
    a_j, b_j = e_j
    return a_j * a_i, a_j * b_i + b_j


def s5_scan(u, a_re, a_im, log_dt, b_re, b_im, init, reverse):
    f32 = jnp.float32
    lam = lax.complex(a_re.astype(f32), a_im.astype(f32))
    lam_bar = jnp.exp(lam * jnp.exp(log_dt.astype(f32))[:, None])
    b_bar = ((lam_bar - 1.0) / lam)[:, :, None] * lax.complex(b_re.astype(f32), b_im.astype(f32))
    uf = u.astype(f32)
    bu = lax.complex(jnp.einsum("gph,blgh->blgp", b_bar.real, uf),
                     jnp.einsum("gph,blgh->blgp", b_bar.imag, uf))
    n = bu.shape[1]
    if init is not None:
        edge = n - 1 if reverse else 0
        bu = bu.at[:, edge].add(lam_bar * init)
    a = jnp.broadcast_to(lam_bar, (1, n) + lam_bar.shape)
    _, states = lax.associative_scan(linear_recurrence, (a, bu), reverse=reverse, axis=1)
    return states


def s5_states(u, lp, d, init, reverse):
    bsz, n, _ = u.shape
    ug = u.reshape(bsz, n, S5_GROUPS, S5_GROUP)
    return s5_scan(ug, lp["s5_a_re"][d], lp["s5_a_im"][d], lp["s5_log_dt"][d],
                   lp["s5_b_re"][d], lp["s5_b_im"][d], init, reverse)


def s5_readout(states, lp, d):
    f32 = jnp.float32
    return (jnp.einsum("ghp,blgp->blgh", lp["s5_c_re"][d].astype(f32), states.real)
            - jnp.einsum("ghp,blgp->blgh", lp["s5_c_im"][d].astype(f32), states.imag))


def centred_short_conv(u, w, b):
    n = u.shape[1]
    up = jnp.pad(u, ((0, 0), (1, 1), (0, 0)))
    return up[:, :n] * w[0] + up[:, 1:n + 1] * w[1] + up[:, 2:] * w[2] + b


def hyena_filters(n, lp):
    f32 = jnp.float32
    pos = jnp.arange(n, dtype=f32)
    t = pos / float(max(n - 1, 1))
    w = 2.0 * math.pi * pos / n
    bands = jnp.linspace(1e-4, HY_BANDS - 1, HY_BANDS, dtype=f32)
    feats = jnp.concatenate([t[:, None], jnp.cos(w[:, None] * bands), -jnp.sin(w[:, None] * bands)], axis=-1)
    h = jnp.sin(lp["hy_f1_freq"].astype(f32) * (feats @ lp["hy_f1_w"].astype(f32) + lp["hy_f1_b"].astype(f32)))
    h = jnp.sin(lp["hy_f2_freq"].astype(f32) * (h @ lp["hy_f2_w"].astype(f32) + lp["hy_f2_b"].astype(f32)))
    h = (h @ lp["hy_f3_w"].astype(f32)).reshape(n, 2, HY_WIDTH)
    window = jnp.exp(-t[:, None, None] * jnp.abs(lp["hy_decay"].astype(f32))[None])
    return h * window


def bidirectional_long_conv(u, h, bias):
    f32 = jnp.float32
    n = u.shape[1]
    h_fwd, h_bwd = h[:, 0], h[:, 1]
    taps = jnp.concatenate([h_fwd, jnp.zeros((1, HY_WIDTH), f32), h_bwd[:0:-1]], axis=0)
    kf = jnp.fft.rfft(taps, n=2 * n, axis=0)
    uf = jnp.fft.rfft(u.astype(f32), n=2 * n, axis=1)
    y = jnp.fft.irfft(uf * kf[None], n=2 * n, axis=1)[:, :n]
    return (y + u.astype(f32) * bias.astype(f32)).astype(u.dtype)


def hyena_branch(hy, lp):
    z = centred_short_conv(hy, lp["hy_conv_w"], lp["hy_conv_b"])
    x0, x1, v = jnp.split(z, 3, axis=-1)
    h = hyena_filters(hy.shape[1], lp)
    return x0 * bidirectional_long_conv(x1 * v, h, lp["hy_bias"])


def mixer_output(u, y_ssm, hy, gates, lp):
    y = (y_ssm.reshape(u.shape) + u.astype(jnp.float32) * lp["s5_d"].astype(jnp.float32)).astype(u.dtype)
    yg = jax.nn.gelu(y)
    glu_v, glu_g = jnp.split(yg @ lp["w_glu"], 2, axis=-1)
    branch_s5 = glu_v * jax.nn.sigmoid(glu_g)
    branch_hy = hyena_branch(hy, lp) @ lp["w_hy_out"]
    gate_s5, gate_hy = jnp.split(gates, 2, axis=-1)
    merged = jax.nn.sigmoid(gate_s5) * branch_s5 + jax.nn.sigmoid(gate_hy) * branch_hy
    return merged @ lp["w_out"]


def swiglu(h, w_in, w_out):
    a, b = jnp.split(h @ w_in, 2, axis=-1)
    return (jax.nn.silu(a) * b) @ w_out


def setup_inputs(seed: int = 0) -> dict:
    key = jax.random.key(seed)
    ks = iter(jax.random.split(key, 48))
    f32 = jnp.float32

    def nrm(shape, scale):
        return jax.random.normal(next(ks), shape, f32) * scale

    L, G, P, H = DEPTH, S5_GROUPS, S5_STATE, S5_GROUP
    n_idx = jnp.arange(P, dtype=f32)
    decay_base = jnp.linspace(math.log(HY_DECAY_TARGET) / HY_SLOW_PCT,
                              math.log(HY_DECAY_TARGET) / HY_FAST_PCT, HY_WIDTH, dtype=f32)
    return {
        "x": nrm((BATCH, SEQ, D_MODEL), 1.0),
        "c": nrm((BATCH, D_MODEL), 1.0),
        "ctx": nrm((BATCH, CTX_LEN, D_MODEL), 1.0),
        "c_ctx": nrm((D_MODEL,), 0.5),
        "w_ada": nrm((L, D_MODEL, N_ADA * D_MODEL), 0.2 * D_MODEL ** -0.5),
        "b_ada": nrm((L, N_ADA * D_MODEL), 0.01),
        "norm_mix": 1.0 + nrm((L, D_MODEL), 0.02),
        "w_in": nrm((L, D_MODEL, IN_COLS), D_MODEL ** -0.5),
        "s5_a_re": -0.5 + nrm((L, 2, G, P), 0.01),
        "s5_a_im": math.pi * n_idx + nrm((L, 2, G, P), 0.01),
        "s5_log_dt": jax.random.uniform(next(ks), (L, 2, G), f32, math.log(DT_MIN), math.log(DT_MAX)),
        "s5_b_re": nrm((L, 2, G, P, H), (2 * H) ** -0.5),
        "s5_b_im": nrm((L, 2, G, P, H), (2 * H) ** -0.5),
        "s5_c_re": nrm((L, 2, G, H, P), 0.5),
        "s5_c_im": nrm((L, 2, G, H, P), 0.5),
        "s5_d": nrm((L, S5_WIDTH), 1.0),
        "w_glu": nrm((L, S5_WIDTH, 2 * D_MODEL), S5_WIDTH ** -0.5),
        "hy_conv_w": nrm((L, SHORT_CONV, 3 * HY_WIDTH), 0.5),
        "hy_conv_b": nrm((L, 3 * HY_WIDTH), 0.01),
        "hy_f1_w": nrm((L, HY_POS_DIM, HY_HIDDEN), HY_POS_DIM ** -0.5),
        "hy_f1_b": nrm((L, HY_HIDDEN), 0.1),
        "hy_f1_freq": 1.0 + nrm((L, HY_HIDDEN), 0.02),
        "hy_f2_w": nrm((L, HY_HIDDEN, HY_HIDDEN), HY_HIDDEN ** -0.5),
        "hy_f2_b": nrm((L, HY_HIDDEN), 0.1),
        "hy_f2_freq": 1.0 + nrm((L, HY_HIDDEN), 0.02),
        "hy_f3_w": nrm((L, HY_HIDDEN, 2 * HY_WIDTH), 0.05 * HY_HIDDEN ** -0.5),
        "hy_decay": decay_base + nrm((L, 2, HY_WIDTH), 0.1),
        "hy_bias": nrm((L, HY_WIDTH), 1.0),
        "w_hy_out": nrm((L, HY_WIDTH, D_MODEL), HY_WIDTH ** -0.5),
        "w_out": nrm((L, D_MODEL, D_MODEL), D_MODEL ** -0.5),
        "norm_ffn": 1.0 + nrm((L, D_MODEL), 0.02),
        "w_ffn_in": nrm((L, D_MODEL, 2 * D_FF), D_MODEL ** -0.5),
        "w_ffn_out": nrm((L, D_FF, D_MODEL), D_FF ** -0.5),
        "norm_f": 1.0 + nrm((D_MODEL,), 0.02),
    }


def reference(x, c, ctx, c_ctx, w_ada, b_ada, norm_mix, w_in, s5_a_re, s5_a_im, s5_log_dt,
              s5_b_re, s5_b_im, s5_c_re, s5_c_im, s5_d, w_glu, hy_conv_w, hy_conv_b,
              hy_f1_w, hy_f1_b, hy_f1_freq, hy_f2_w, hy_f2_b, hy_f2_freq, hy_f3_w, hy_decay,
              hy_bias, w_hy_out, w_out, norm_ffn, w_ffn_in, w_ffn_out, norm_f):
    n_lat = x.shape[1]
    n_rows = n_lat // GRID_W
    x = x + sincos_2d(n_rows, D_MODEL).astype(x.dtype)[None]
    silu_c = jax.nn.silu(c)
    silu_cc = jax.nn.silu(c_ctx)[None]

    for l in range(DEPTH):
        lp = {
            "s5_a_re": s5_a_re[l], "s5_a_im": s5_a_im[l], "s5_log_dt": s5_log_dt[l],
            "s5_b_re": s5_b_re[l], "s5_b_im": s5_b_im[l],
            "s5_c_re": s5_c_re[l], "s5_c_im": s5_c_im[l],
            "s5_d": s5_d[l], "w_glu": w_glu[l],
            "hy_conv_w": hy_conv_w[l], "hy_conv_b": hy_conv_b[l],
            "hy_f1_w": hy_f1_w[l], "hy_f1_b": hy_f1_b[l], "hy_f1_freq": hy_f1_freq[l],
            "hy_f2_w": hy_f2_w[l], "hy_f2_b": hy_f2_b[l], "hy_f2_freq": hy_f2_freq[l],
            "hy_f3_w": hy_f3_w[l], "hy_decay": hy_decay[l], "hy_bias": hy_bias[l],
            "w_hy_out": w_hy_out[l], "w_out": w_out[l],
        }
        shift_mix, scale_mix, gate_mix, shift_ffn, scale_ffn, gate_ffn = jnp.split(
            silu_c @ w_ada[l] + b_ada[l], N_ADA, axis=-1)
        cshift_mix, cscale_mix, cgate_mix, cshift_ffn, cscale_ffn, cgate_ffn = jnp.split(
            silu_cc @ w_ada[l] + b_ada[l], N_ADA, axis=-1)

        h_c = modulate(ctx, norm_mix[l], cshift_mix, cscale_mix)
        u_c = h_c @ w_in[l][:, :S5_WIDTH]
        st_ctx_f = s5_states(u_c, lp, 0, None, False)
        st_ctx_b = s5_states(u_c, lp, 1, None, True)

        h_x = modulate(x, norm_mix[l], shift_mix, scale_mix)
        p_x = h_x @ w_in[l]
        u_x, hy_x, gates_x = jnp.split(p_x, [S5_WIDTH, S5_WIDTH + 3 * HY_WIDTH], axis=-1)
        y_x = (s5_readout(s5_states(u_x, lp, 0, st_ctx_f[:, -1], False), lp, 0)
               + s5_readout(s5_states(u_x, lp, 1, st_ctx_b[:, 0], True), lp, 1))
        x = x + gate_mix[:, None] * mixer_output(u_x, y_x, hy_x, gates_x, lp)
        x = x + gate_ffn[:, None] * swiglu(modulate(x, norm_ffn[l], shift_ffn, scale_ffn),
                                           w_ffn_in[l], w_ffn_out[l])

        if l < DEPTH - 1:
            hy_c, gates_c = jnp.split(h_c @ w_in[l][:, S5_WIDTH:], [3 * HY_WIDTH], axis=-1)
            y_c = s5_readout(st_ctx_f, lp, 0) + s5_readout(st_ctx_b, lp, 1)
            ctx = ctx + cgate_mix[:, None] * mixer_output(u_c, y_c, hy_c, gates_c, lp)
            ctx = ctx + cgate_ffn[:, None] * swiglu(modulate(ctx, norm_ffn[l], cshift_ffn, cscale_ffn),
                                                    w_ffn_in[l], w_ffn_out[l])

    return rms_norm(x, norm_f)
```

```cpp
#include <hip/hip_runtime.h>
#include <hip/hip_cooperative_groups.h>
#include <cstdio>
#include <cstdint>
namespace cg = cooperative_groups;
namespace pg8 {
#define PG8_LAS __attribute__((address_space(3)))
typedef unsigned short bf16_t;
typedef short bf16x8 __attribute__((ext_vector_type(8)));
typedef float f32x4 __attribute__((ext_vector_type(4)));
typedef unsigned u32x4 __attribute__((ext_vector_type(4)));
constexpr int BM = 256, BK = 64, HALF = 128, HTB = HALF * BK * 2  , STAGE_BYTES = 8 * HTB, NXCD = 8, WGM = 8;

__host__ __device__ __forceinline__ int lds_byte(int r, int c) { const int st = (r >> 4) * 2 + (c >> 5), rr = r & 15, cc = c & 31, ob = rr * 64 + cc * 2; return st * 1024 + (ob ^ (((ob >> 9) & 1) << 5)); }
__host__ __device__ __forceinline__ void stage_rc(int b, int& R, int& C) { const int st = b / 1024, sb = b % 1024, swz = sb ^ (((sb >> 9) & 1) << 5); R = (st >> 1) * 16 + swz / 64; C = (st & 1) * 32 + (swz % 64) / 2; }
__host__ __device__ __forceinline__ int perm32(int rho) { const int n = rho >> 4, i = rho & 15; return 8 * (i >> 2) + 4 * n + (i & 3); }

struct Unit { int pm, pn; };
struct Gemm { const bf16_t* A; const bf16_t* Bt; int M, N, K; };

struct StaticOrder {
    int nM, nN, nwg, G, c;
    __host__ __device__ void init(int M, int N, int G_, int c_) { nM = M / BM; nN = N / BM; nwg = nM * nN; G = G_; c = c_; }
    __host__ __device__ bool next(int i, Unit& u) const {
        const long L = (long)i * G + c; if (L >= nwg) return false;
        int wgid = (int)L; { const int q = nwg / NXCD, r = nwg % NXCD, xcd = wgid % NXCD, off = wgid / NXCD; wgid = (xcd < r ? xcd * (q + 1) : r * (q + 1) + (xcd - r) * q) + off; }
        const int nig = WGM * nN, gid = wgid / nig, fm = gid * WGM, gsz = (nM - fm) < WGM ? (nM - fm) : WGM;
        u.pm = fm + ((wgid % nig) % gsz); u.pn = (wgid % nig) / gsz; return true;
    }
    __device__ __forceinline__ void a_ready(const Unit&) const {}
    __device__ __forceinline__ void done(const Unit&) const {}
};
__device__ __forceinline__ unsigned cvt_pk_bf16(float lo, float hi) { unsigned r; asm volatile("v_cvt_pk_bf16_f32 %0, %1, %2" : "=v"(r) : "v"(lo), "v"(hi)); return r; }
typedef float f32x2 __attribute__((ext_vector_type(2)));
typedef unsigned u32x2 __attribute__((ext_vector_type(2)));
__device__ __forceinline__ float bf_lo(unsigned w) { return __uint_as_float(w << 16); }
__device__ __forceinline__ float bf_hi(unsigned w) { return __uint_as_float(w & 0xffff0000u); }
__device__ __forceinline__ float sigm(float x) { return 1.0f / (1.0f + __expf(-x)); }

struct EpiStoreBf16 {
    static constexpr bool PERM = true, AFTER_DRAIN = false;
    bf16_t* O; int ldc;
    __device__ __forceinline__ void operator()(const f32x4 (&acc)[2][2][4][2], const Unit& u, int wr, int wc, int fr, int fq) const {
        const int row0 = u.pm * BM + wr * 64 + fr, col0 = u.pn * BM + wc * 32 + 8 * fq;
#pragma unroll
        for (int ai = 0; ai < 2; ++ai)
#pragma unroll
            for (int m = 0; m < 4; ++m) { bf16_t* rowp = O + (size_t)(row0 + ai * HALF + m * 16) * ldc + col0;
#pragma unroll
                for (int bj = 0; bj < 2; ++bj) { const f32x4 v0 = acc[ai][bj][m][0], v1 = acc[ai][bj][m][1];
                    u32x4 w; w.x = cvt_pk_bf16(v0[0], v0[1]); w.y = cvt_pk_bf16(v0[2], v0[3]); w.z = cvt_pk_bf16(v1[0], v1[1]); w.w = cvt_pk_bf16(v1[2], v1[3]);
                    *(u32x4*)(rowp + bj * HALF) = w; } }
    }
};
struct EpiHyOut {
    static constexpr bool PERM = true, AFTER_DRAIN = false;
    bf16_t* O; const bf16_t* gates;
    __device__ __forceinline__ void operator()(const f32x4 (&acc)[2][2][4][2], const Unit& u, int wr, int wc, int fr, int fq) const {
        const int row0 = u.pm * BM + wr * 64 + fr, col0 = u.pn * BM + wc * 32 + 8 * fq;
#pragma unroll
        for (int ai = 0; ai < 2; ++ai)
#pragma unroll
            for (int m = 0; m < 4; ++m) { const size_t row = (size_t)(row0 + ai * HALF + m * 16);
#pragma unroll
                for (int bj = 0; bj < 2; ++bj) { const f32x4 v0 = acc[ai][bj][m][0], v1 = acc[ai][bj][m][1];
                    const u32x4 g = *(const u32x4*)(gates + row * 4096 + 2048 + col0 + bj * HALF);
                    u32x4 w; w.x = cvt_pk_bf16(v0[0] * sigm(bf_lo(g.x)), v0[1] * sigm(bf_hi(g.x))); w.y = cvt_pk_bf16(v0[2] * sigm(bf_lo(g.y)), v0[3] * sigm(bf_hi(g.y)));
                    w.z = cvt_pk_bf16(v1[0] * sigm(bf_lo(g.z)), v1[1] * sigm(bf_hi(g.z))); w.w = cvt_pk_bf16(v1[2] * sigm(bf_lo(g.w)), v1[3] * sigm(bf_hi(g.w)));
                    *(u32x4*)(O + row * 2048 + col0 + bj * HALF) = w; } }
    }
};
struct EpiGlu {
    static constexpr bool PERM = true, AFTER_DRAIN = false;
    bf16_t* O; const bf16_t* gates; const bf16_t* mhy;
    __device__ __forceinline__ void operator()(const f32x4 (&acc)[2][2][4][2], const Unit& u, int wr, int wc, int fr, int fq) const {
        const int row0 = u.pm * BM + wr * 64 + fr, j0 = (u.pn * BM + wc * 32 + 8 * fq) >> 1;
#pragma unroll
        for (int ai = 0; ai < 2; ++ai)
#pragma unroll
            for (int m = 0; m < 4; ++m) { const size_t row = (size_t)(row0 + ai * HALF + m * 16);
#pragma unroll
                for (int bj = 0; bj < 2; ++bj) { const f32x4 v = acc[ai][bj][m][0], g = acc[ai][bj][m][1]; const int j = j0 + bj * 64;
                    const u32x2 gs = *(const u32x2*)(gates + row * 4096 + j); const u32x2 mh = *(const u32x2*)(mhy + row * 2048 + j);
                    const float o0 = sigm(bf_lo(gs.x)) * v[0] * sigm(g[0]) + bf_lo(mh.x), o1 = sigm(bf_hi(gs.x)) * v[1] * sigm(g[1]) + bf_hi(mh.x);
                    const float o2 = sigm(bf_lo(gs.y)) * v[2] * sigm(g[2]) + bf_lo(mh.y), o3 = sigm(bf_hi(gs.y)) * v[3] * sigm(g[3]) + bf_hi(mh.y);
                    u32x2 w; w.x = cvt_pk_bf16(o0, o1); w.y = cvt_pk_bf16(o2, o3);
                    *(u32x2*)(O + row * 2048 + j) = w; } }
    }
};
struct EpiSwiglu {
    static constexpr bool PERM = true, AFTER_DRAIN = false;
    bf16_t* O;
    __device__ __forceinline__ void operator()(const f32x4 (&acc)[2][2][4][2], const Unit& u, int wr, int wc, int fr, int fq) const {
        const int row0 = u.pm * BM + wr * 64 + fr, j0 = (u.pn * BM + wc * 32 + 8 * fq) >> 1;
#pragma unroll
        for (int ai = 0; ai < 2; ++ai)
#pragma unroll
            for (int m = 0; m < 4; ++m) { const size_t row = (size_t)(row0 + ai * HALF + m * 16);
#pragma unroll
                for (int bj = 0; bj < 2; ++bj) { const f32x4 a = acc[ai][bj][m][0], b = acc[ai][bj][m][1]; const int j = j0 + bj * 64;
                    u32x2 w; w.x = cvt_pk_bf16(a[0] * sigm(a[0]) * b[0], a[1] * sigm(a[1]) * b[1]); w.y = cvt_pk_bf16(a[2] * sigm(a[2]) * b[2], a[3] * sigm(a[3]) * b[3]);
                    *(u32x2*)(O + row * 5632 + j) = w; } }
    }
};
struct EpiRes {
    static constexpr bool PERM = false, AFTER_DRAIN = false;
    const float* base; float* out; const float* gate  ; int ldg; const float* TR; const float* TC; float* rsq;
    __device__ __forceinline__ void operator()(const f32x4 (&acc)[2][2][4][2], const Unit& u, int wr, int wc, int fr, int fq) const {
        const int row0 = u.pm * BM + wr * 64 + fr, col0 = u.pn * BM + wc * 32 + 4 * fq;
        const int b = (u.pm * BM) >> 13;
        f32x4 gv[2][2];
#pragma unroll
        for (int bj = 0; bj < 2; ++bj)
#pragma unroll
            for (int n = 0; n < 2; ++n) gv[bj][n] = *(const f32x4*)(gate + (size_t)b * ldg + col0 + bj * HALF + n * 16);
#pragma unroll
        for (int ai = 0; ai < 2; ++ai)
#pragma unroll
            for (int m = 0; m < 4; ++m) { const int row = row0 + ai * HALF + m * 16; const size_t off = (size_t)row * 2048 + col0; float ss = 0.f;
                const float* pp = nullptr;
                if (TR) { const int t = row & 8191; pp = (col0 < 1024) ? (TR + (size_t)(t >> 6) * 1024 + col0) : (TC + (size_t)(t & 63) * 1024 + (col0 - 1024)); }
#pragma unroll
                for (int bj = 0; bj < 2; ++bj)
#pragma unroll
                    for (int n = 0; n < 2; ++n) { f32x4 bs = *(const f32x4*)(base + off + bj * HALF + n * 16);
                        if (TR) bs += *(const f32x4*)(pp + bj * HALF + n * 16);
                        const f32x4 o = bs + gv[bj][n] * acc[ai][bj][m][n];
                        ss += (o[0] * o[0] + o[1] * o[1]) + (o[2] * o[2] + o[3] * o[3]);
                        *(f32x4*)(out + off + bj * HALF + n * 16) = o; }
                ss += __shfl_xor(ss, 16); ss += __shfl_xor(ss, 32);
                if (fq == 0) rsq[(size_t)row * 32 + u.pn * 4 + wc] = ss; }
    }
};
template <class Epi, class Sched, bool ALIGN_EPI = false, bool SP2 = false>
__device__ __forceinline__ void gemm_phase(PG8_LAS unsigned char* lds, const Gemm g, const Sched& S, const Epi& E) {
    const int tid = threadIdx.x, wid = __builtin_amdgcn_readfirstlane(tid >> 6), lane = tid & 63, wr = wid >> 2, wc = wid & 3, fr = lane & 15, fq = lane >> 4;
    const int K = g.K, nt = K / BK;
    unsigned voffA[2], voffB[2];
#pragma unroll
    for (int i = 0; i < 2; ++i) { int R, C; stage_rc(tid * 16 + i * 8192, R, C); const int Rb = Epi::PERM ? ((R & ~31) + perm32(R & 31)) : R;
        voffA[i] = (unsigned)(R * K + C) * 2u; voffB[i] = (unsigned)(Rb * K + C) * 2u; }
    const size_t kstep = (size_t)(BK * 2);
    const size_t hstep = (size_t)HALF * K * 2;
    const size_t tstep = 2 * hstep;
    const unsigned ldsw = (unsigned)wid * 1024u;
    const int aoff = lds_byte(wr * 64 + fr, fq * 8), boff = lds_byte(wc * 32 + fr, fq * 8);
#define PG8_SA(b, h) (((b) * 2 + (h)) * HTB)
#define PG8_SB(b, h) ((4 + (b) * 2 + (h)) * HTB)
#define PG8_STAGE(bufoff, gbase, voff) do { _Pragma("unroll") for (int _i = 0; _i < 2; ++_i) \
        __builtin_amdgcn_global_load_lds((const unsigned*)((const char*)(gbase) + (voff)[_i]), (PG8_LAS unsigned*)(lds + (bufoff) + ldsw + _i * 8192), 16, 0, 0); } while (0)
#define PG8_LDA(dst, b, h) do { _Pragma("unroll") for (int m = 0; m < 4; ++m) _Pragma("unroll") for (int k = 0; k < 2; ++k) dst[m][k] = *(const PG8_LAS bf16x8*)(lds + PG8_SA(b, h) + aoff + m * 2048 + k * 1024); } while (0)
#define PG8_LDB(dst, b, h) do { _Pragma("unroll") for (int n = 0; n < 2; ++n) _Pragma("unroll") for (int k = 0; k < 2; ++k) dst[n][k] = *(const PG8_LAS bf16x8*)(lds + PG8_SB(b, h) + boff + n * 2048 + k * 1024); } while (0)
#define PG8_MMA(ai, bj, At, Bt) do { __builtin_amdgcn_s_setprio(1); _Pragma("unroll") for (int m = 0; m < 4; ++m) _Pragma("unroll") for (int n = 0; n < 2; ++n) _Pragma("unroll") for (int k = 0; k < 2; ++k) \
        acc[ai][bj][m][n] = __builtin_amdgcn_mfma_f32_16x16x32_bf16(Bt[n][k], At[m][k], acc[ai][bj][m][n], 0, 0, 0); __builtin_amdgcn_s_setprio(0); } while (0)
#define PG8_WAIT_V(n) asm volatile("s_waitcnt vmcnt(" #n ")" ::: "memory")
#define PG8_WAIT_L(n) asm volatile("s_waitcnt lgkmcnt(" #n ")" ::: "memory")
#define PG8_BAR __builtin_amdgcn_s_barrier()
#define PG8_SCHED __builtin_amdgcn_sched_barrier(0)
    Unit cur, nxt; int ui = 0;
    if (!S.next(0, cur)) return;
    f32x4 acc[2][2][4][2];
#pragma unroll
    for (int a = 0; a < 2; ++a)
#pragma unroll
        for (int b = 0; b < 2; ++b)
#pragma unroll
            for (int m = 0; m < 4; ++m)
#pragma unroll
                for (int n = 0; n < 2; ++n) acc[a][b][m][n] = (f32x4){0.f, 0.f, 0.f, 0.f};
    bf16x8 At[4][2], B0[2][2], B1[2][2];
    const char* cA = (const char*)g.A + (size_t)cur.pm * tstep; const char* cB = (const char*)g.Bt + (size_t)cur.pn * tstep;
    S.a_ready(cur);
    if constexpr (SP2) {
        PG8_STAGE(PG8_SB(0, 0), cB, voffB); PG8_STAGE(PG8_SB(0, 1), cB + hstep, voffB); PG8_STAGE(PG8_SA(0, 0), cA, voffA); PG8_STAGE(PG8_SA(0, 1), cA + hstep, voffA);
        if (wr == 1) PG8_BAR;
        PG8_WAIT_V(2); PG8_BAR;
        PG8_STAGE(PG8_SB(1, 0), cB + kstep, voffB); PG8_STAGE(PG8_SA(1, 0), cA + kstep, voffA); PG8_STAGE(PG8_SB(1, 1), cB + hstep + kstep, voffB);
        PG8_WAIT_V(6); PG8_BAR;
    } else {
        PG8_STAGE(PG8_SB(0, 0), cB, voffB); PG8_STAGE(PG8_SA(0, 0), cA, voffA); PG8_STAGE(PG8_SB(0, 1), cB + hstep, voffB); PG8_STAGE(PG8_SA(0, 1), cA + hstep, voffA);
        if (wr == 1) PG8_BAR;
        PG8_WAIT_V(4); PG8_BAR;
        PG8_STAGE(PG8_SB(1, 0), cB + kstep, voffB); PG8_STAGE(PG8_SA(1, 0), cA + kstep, voffA); PG8_STAGE(PG8_SB(1, 1), cB + hstep + kstep, voffB);
        PG8_WAIT_V(6); PG8_BAR;
    }
    for (;;) {
        const bool has_next = S.next(ui + 1, nxt);
        const char* nA = has_next ? (const char*)g.A + (size_t)nxt.pm * tstep : cA; const char* nB = has_next ? (const char*)g.Bt + (size_t)nxt.pn * tstep : cB;
        for (int t = 0; t < nt; t += 2) {
            const bool last = (t == nt - 2);
            const char* a1 = cA + (size_t)(t + 1) * kstep;
            const char* a2 = last ? nA : cA + (size_t)(t + 2) * kstep; const char* b2 = last ? nB : cB + (size_t)(t + 2) * kstep;
            const char* a3 = a2 + kstep; const char* b3 = b2 + kstep;
            if (last && has_next) S.a_ready(nxt);
            if constexpr (SP2) {
            PG8_LDB(B0, 0, 0); PG8_LDB(B1, 0, 1); PG8_SCHED; PG8_LDA(At, 0, 0); PG8_STAGE(PG8_SA(1, 1), a1 + hstep, voffA);
            PG8_WAIT_V(8); PG8_WAIT_L(0); PG8_BAR; PG8_MMA(0, 0, At, B0); PG8_MMA(0, 1, At, B1); PG8_BAR; PG8_SCHED;
            PG8_LDA(At, 0, 1); PG8_STAGE(PG8_SB(0, 0), b2, voffB); PG8_STAGE(PG8_SB(0, 1), b2 + hstep, voffB); PG8_STAGE(PG8_SA(0, 0), a2, voffA);
            PG8_WAIT_V(8); PG8_WAIT_L(0); PG8_BAR; PG8_MMA(1, 0, At, B0); PG8_MMA(1, 1, At, B1); PG8_BAR; PG8_SCHED;
            PG8_LDB(B0, 1, 0); PG8_LDB(B1, 1, 1); PG8_SCHED; PG8_LDA(At, 1, 0); PG8_STAGE(PG8_SA(0, 1), a2 + hstep, voffA);
            PG8_WAIT_V(8); PG8_WAIT_L(0); PG8_BAR; PG8_MMA(0, 0, At, B0); PG8_MMA(0, 1, At, B1); PG8_BAR; PG8_SCHED;
            PG8_LDA(At, 1, 1); PG8_STAGE(PG8_SB(1, 0), b3, voffB); PG8_STAGE(PG8_SB(1, 1), b3 + hstep, voffB); PG8_STAGE(PG8_SA(1, 0), a3, voffA);
            PG8_WAIT_V(8); PG8_WAIT_L(0); PG8_BAR; PG8_MMA(1, 0, At, B0); PG8_MMA(1, 1, At, B1); PG8_BAR; PG8_SCHED;
            } else {
            PG8_LDB(B0, 0, 0); PG8_SCHED; PG8_LDA(At, 0, 0); PG8_STAGE(PG8_SA(1, 1), a1 + hstep, voffA);
            PG8_WAIT_L(8); PG8_BAR; PG8_WAIT_L(0); PG8_MMA(0, 0, At, B0); PG8_BAR; PG8_SCHED;
            PG8_LDB(B1, 0, 1); PG8_STAGE(PG8_SB(0, 0), b2, voffB);
            PG8_BAR; PG8_WAIT_L(0); PG8_MMA(0, 1, At, B1); PG8_BAR;
            PG8_LDA(At, 0, 1); PG8_STAGE(PG8_SA(0, 0), a2, voffA);
            PG8_BAR; PG8_WAIT_L(0); PG8_MMA(1, 0, At, B0); PG8_BAR; PG8_SCHED;
            PG8_STAGE(PG8_SB(0, 1), b2 + hstep, voffB);
            PG8_WAIT_V(6); PG8_BAR; PG8_MMA(1, 1, At, B1); PG8_BAR;
            PG8_LDB(B0, 1, 0); PG8_SCHED; PG8_LDA(At, 1, 0); PG8_STAGE(PG8_SA(0, 1), a2 + hstep, voffA);
            PG8_WAIT_L(8); PG8_BAR; PG8_WAIT_L(0); PG8_MMA(0, 0, At, B0); PG8_BAR; PG8_SCHED;
            PG8_LDB(B1, 1, 1); PG8_STAGE(PG8_SB(1, 0), b3, voffB);
            PG8_BAR; PG8_WAIT_L(0); PG8_MMA(0, 1, At, B1); PG8_BAR;
            PG8_LDA(At, 1, 1); PG8_STAGE(PG8_SA(1, 0), a3, voffA);
            PG8_BAR; PG8_WAIT_L(0); PG8_MMA(1, 0, At, B0); PG8_BAR; PG8_SCHED;
            PG8_STAGE(PG8_SB(1, 1), b3 + hstep, voffB);
            PG8_WAIT_V(6); PG8_BAR; PG8_MMA(1, 1, At, B1); PG8_BAR;
            }
        }
        if constexpr (ALIGN_EPI) { if (wr == 0) PG8_BAR; }
        if constexpr (!Epi::AFTER_DRAIN) { E(acc, cur, wr, wc, fr, fq); S.done(cur); }
        if (!has_next) break;
#pragma unroll
        for (int a = 0; a < 2; ++a)
#pragma unroll
            for (int b = 0; b < 2; ++b)
#pragma unroll
                for (int m = 0; m < 4; ++m)
#pragma unroll
                    for (int n = 0; n < 2; ++n) acc[a][b][m][n] = (f32x4){0.f, 0.f, 0.f, 0.f};
        cur = nxt; cA = nA; cB = nB; ++ui;
        if constexpr (ALIGN_EPI) { if (wr == 1) PG8_BAR; }
    }
    PG8_WAIT_V(0);
    if constexpr (!ALIGN_EPI) { if (wr == 0) PG8_BAR; }
    PG8_BAR;
    if constexpr (Epi::AFTER_DRAIN) { E.fused(acc, cur, wr, wc, fr, fq, lds, wid, lane); S.done(cur); }
#undef PG8_SA
#undef PG8_SB
#undef PG8_STAGE
#undef PG8_LDA
#undef PG8_LDB
#undef PG8_MMA
#undef PG8_WAIT_V
#undef PG8_WAIT_L
#undef PG8_BAR
#undef PG8_SCHED
}
}
constexpr int NWAVES = 8, NTHR = 512;
constexpr int D = 2048, NB = 2, SEQ = 8192, M = NB * SEQ, CTX = 256, MC = NB * CTX, MA = M + MC;
constexpr int S5W = 1024, SG = 64, SP = 64, SH = 16, HYW = 1024, DFF = 5632, INC = 8192, NADA = 6 * D;
constexpr float EPS = 1e-6f;
constexpr size_t MiB = 1u << 20;
constexpr size_t WS_ADA = 0;
constexpr size_t WS_ZERO_BYTES = 256 * 1024;
constexpr size_t WS_TR = 1 * MiB;
constexpr size_t WS_TC = WS_TR + 512 * 1024;
constexpr size_t WS_LAMB = 2 * MiB;
constexpr size_t WS_BBAR = WS_LAMB + 64 * 1024;
constexpr size_t WS_H2 = 4 * MiB;
constexpr size_t WS_RSQ1 = 6 * MiB, WS_RSQ2 = 8 * MiB;
constexpr size_t WS_ADAP = 10 * MiB;
constexpr size_t WS_SLOC = 13 * MiB;
constexpr size_t WS_WIN = 16 * MiB, WS_WGLU = 48 * MiB, WS_WHY = 56 * MiB, WS_WOUT = 60 * MiB, WS_WF1 = 68 * MiB, WS_WF2 = 112 * MiB;
constexpr size_t WS_A = 134 * MiB;
constexpr size_t WS_U = 200 * MiB;
constexpr size_t WS_GATES = 233 * MiB;
constexpr size_t WS_HYT = 361 * MiB;
constexpr size_t WS_YG = 361 * MiB, WS_MERGED = 393 * MiB;
constexpr size_t WS_HYB = 457 * MiB;
constexpr size_t WS_END = 489 * MiB;
constexpr int LDS_BYTES = 147456;

#define LAS __attribute__((address_space(3)))
typedef unsigned short bf16;
typedef unsigned v4u __attribute__((ext_vector_type(4)));
typedef unsigned v2u __attribute__((ext_vector_type(2)));
typedef float f32x4 __attribute__((ext_vector_type(4)));
#define LDS_WAIT() asm volatile("s_waitcnt lgkmcnt(0)" ::: "memory")
__device__ __forceinline__ unsigned f2bf(float f) { unsigned u = __builtin_bit_cast(unsigned, f); return (u + 0x7fffu + ((u >> 16) & 1u)) >> 16; }
__device__ __forceinline__ unsigned pk2(float lo, float hi) { return f2bf(lo) | (f2bf(hi) << 16); }
__device__ __forceinline__ float bf2f(bf16 v) { return __uint_as_float(((unsigned)v) << 16); }
__device__ __forceinline__ float wave_sum(float v) {
#pragma unroll
    for (int o = 1; o < 64; o <<= 1) v += __shfl_xor(v, o);
    return v;
}
__device__ __forceinline__ float silu_f(float x) { return x / (1.0f + __expf(-x)); }
__device__ __forceinline__ float gelu_tanh(float y) { const float z = 0.7978845608028654f * (y + 0.044715f * y * y * y); const float e = __expf(2.0f * z); return y * (1.0f - 1.0f / (e + 1.0f)); }

struct Args { const float* in[34]; float* out; unsigned char* ws; int ph_lo, ph_hi; };
struct Frame {
    LAS unsigned char* lds; int tid, lane, wave, bid, G;
    const float* in[34]; float* out; unsigned char* ws;
};
enum { I_X = 0, I_C, I_CTX, I_CCTX, I_WADA, I_BADA, I_NMIX, I_WIN, I_ARE, I_AIM, I_LOGDT, I_BRE, I_BIM, I_CRE, I_CIM, I_S5D, I_WGLU, I_CONVW, I_CONVB,
       I_F1W, I_F1B, I_F1F, I_F2W, I_F2B, I_F2F, I_F3W, I_DECAY, I_HBIAS, I_WHY, I_WOUT, I_NFFN, I_WF1, I_WF2, I_NF };

template <bool ILV> __device__ __forceinline__ void transpose_item(const float* W, int K, int N, bf16* WT, LAS float* scr, int item, int lane) {
    const int nblk = N / 32, kb = item / nblk, nb = item % nblk, k0 = 64 * kb, n0 = 32 * nb;
#pragma unroll 8
    for (int i = 0; i < 32; ++i) { const int kk = 2 * i + (lane >> 5); scr[kk * 33 + (lane & 31)] = W[(size_t)(k0 + kk) * N + n0 + (lane & 31)]; }
    LDS_WAIT(); asm volatile("" ::: "memory");
    const int c = lane & 7;
#pragma unroll
    for (int j = 0; j < 4; ++j) { const int n = (lane >> 3) + 8 * j; const LAS float* s = scr + (8 * c) * 33 + n;
        v4u o; o.x = pk2(s[0 * 33], s[1 * 33]); o.y = pk2(s[2 * 33], s[3 * 33]); o.z = pk2(s[4 * 33], s[5 * 33]); o.w = pk2(s[6 * 33], s[7 * 33]);
        int dr = n0 + n;
        if (ILV) { const int half = N >> 1, isg = dr >= half, jj = dr - (isg ? half : 0); dr = 8 * (jj >> 2) + (isg ? 4 : 0) + (jj & 3); }
        *(v4u*)(WT + (size_t)dr * K + k0 + 8 * c) = o; }
    LDS_WAIT(); asm volatile("" ::: "memory");
}
__device__ __forceinline__ void p0_prologue(Frame& F) {
    if (F.bid < 96) {
        LAS float* sc = (LAS float*)F.lds;
        const int ks = F.bid / 6, cb = F.bid % 6, k0 = ks * 128;
        if (F.tid < 384) { const int b = F.tid >> 7, kk = F.tid & 127; const float v = (b < 2) ? F.in[I_C][b * D + k0 + kk] : F.in[I_CCTX][k0 + kk]; sc[F.tid] = silu_f(v); }
        __syncthreads();
        const int col = cb * 2048 + F.tid * 4;
        const float* W = F.in[I_WADA] + (size_t)k0 * NADA + col;
        f32x4 a0 = {0, 0, 0, 0}, a1 = a0, a2 = a0;
#pragma unroll 8
        for (int k = 0; k < 128; ++k) { const f32x4 w = *(const f32x4*)(W + (size_t)k * NADA); a0 += sc[k] * w; a1 += sc[128 + k] * w; a2 += sc[256 + k] * w; }
        float* adap = (float*)(F.ws + WS_ADAP) + (size_t)ks * 3 * NADA;
        *(f32x4*)(adap + col) = a0; *(f32x4*)(adap + NADA + col) = a1; *(f32x4*)(adap + 2 * NADA + col) = a2;
        __syncthreads();
    }
    const int gw = F.bid * NWAVES + F.wave, NGW = F.G * NWAVES, gt = F.bid * NTHR + F.tid, NGT = F.G * NTHR;
    {
        LAS float* scr = (LAS float*)(F.lds + F.wave * 8704);
        constexpr int I1 = (D / 64) * (INC / 32), I2 = (S5W / 64) * (2 * D / 32), I3 = (HYW / 64) * (D / 32), I4 = (D / 64) * (D / 32), I5 = (D / 64) * (2 * DFF / 32), I6 = (DFF / 64) * (D / 32);
        constexpr int NITEMS = I1 + I2 + I3 + I4 + I5 + I6;
        for (int it = gw; it < NITEMS; it += NGW) {
            int r = it;
            if (r < I1) { transpose_item<false>(F.in[I_WIN], D, INC, (bf16*)(F.ws + WS_WIN), scr, r, F.lane); continue; } r -= I1;
            if (r < I2) { transpose_item<true>(F.in[I_WGLU], S5W, 2 * D, (bf16*)(F.ws + WS_WGLU), scr, r, F.lane); continue; } r -= I2;
            if (r < I3) { transpose_item<false>(F.in[I_WHY], HYW, D, (bf16*)(F.ws + WS_WHY), scr, r, F.lane); continue; } r -= I3;
            if (r < I4) { transpose_item<false>(F.in[I_WOUT], D, D, (bf16*)(F.ws + WS_WOUT), scr, r, F.lane); continue; } r -= I4;
            if (r < I5) { transpose_item<true>(F.in[I_WF1], D, 2 * DFF, (bf16*)(F.ws + WS_WF1), scr, r, F.lane); continue; } r -= I5;
            transpose_item<false>(F.in[I_WF2], DFF, D, (bf16*)(F.ws + WS_WF2), scr, r, F.lane);
        }
    }
    {
        float* TR = (float*)(F.ws + WS_TR); float* TC = (float*)(F.ws + WS_TC);
        for (int i = gt; i < 192 * 1024; i += NGT) { const int r = i >> 10, c = i & 1023, k = c & 511;
            const float omega = (float)exp(-(double)k * (9.210340371976184 / 512.0));
            const float ang = (float)(r < 128 ? r : r - 128) * omega;
            const float v = (c < 512) ? (float)sin((double)ang) : (float)cos((double)ang);
            if (r < 128) TR[(size_t)r * 1024 + c] = v; else TC[(size_t)(r - 128) * 1024 + c] = v; }
    }
    {
        float2* LAMB = (float2*)(F.ws + WS_LAMB); float2* BBAR = (float2*)(F.ws + WS_BBAR);
        for (int i = gt; i < 2 * SG * SP; i += NGT) { const int dg = i >> 6;
            const double are = F.in[I_ARE][i], aim = F.in[I_AIM][i], dt = exp((double)F.in[I_LOGDT][dg]);
            const double mag = exp(are * dt), lr = mag * cos(aim * dt), li = mag * sin(aim * dt);
            LAMB[i] = make_float2((float)lr, (float)li);
            const double den = are * are + aim * aim, qr = ((lr - 1.0) * are + li * aim) / den, qi = (li * are - (lr - 1.0) * aim) / den;
#pragma unroll 4
            for (int h = 0; h < SH; ++h) { const double br = F.in[I_BRE][(size_t)i * SH + h], bi = F.in[I_BIM][(size_t)i * SH + h];
                BBAR[(size_t)i * SH + h] = make_float2((float)(qr * br - qi * bi), (float)(qr * bi + qi * br)); } }
    }
    {
        float* H2 = (float*)(F.ws + WS_H2);
        const int k = F.lane;
        for (int n = gw; n < SEQ; n += NGW) {
            const double t = (double)n / 8191.0, w = 6.283185307179586 * (double)n / 8192.0;
            float feat;
            if (k == 0) feat = (float)t;
            else if (k <= 16) { const double band = 1e-4 + (double)(k - 1) * ((15.0 - 1e-4) / 15.0); feat = (float)cos(w * band); }
            else if (k <= 32) { const double band = 1e-4 + (double)(k - 17) * ((15.0 - 1e-4) / 15.0); feat = (float)(-sin(w * band)); }
            else feat = 0.f;
            float a = F.in[I_F1B][k];
#pragma unroll
            for (int i = 0; i < 33; ++i) a += __shfl(feat, i) * F.in[I_F1W][i * 64 + k];
            const float h1 = sinf(F.in[I_F1F][k] * a);
            float a2 = F.in[I_F2B][k];
#pragma unroll 8
            for (int j = 0; j < 64; ++j) a2 += __shfl(h1, j) * F.in[I_F2W][j * 64 + k];
            H2[(size_t)n * 64 + k] = sinf(F.in[I_F2F][k] * a2);
        }
    }
}
__device__ __forceinline__ void p1_modulate(Frame& F) {
    const int gw = F.bid * NWAVES + F.wave, NGW = F.G * NWAVES;
    const float* TR = (const float*)(F.ws + WS_TR); const float* TC = (const float*)(F.ws + WS_TC);
    bf16* HA = (bf16*)(F.ws + WS_A);
    LAS float* ada = (LAS float*)F.lds;
    const float* adap = (const float*)(F.ws + WS_ADAP);
    for (int e = F.tid; e < 3 * 4096; e += NTHR) { const int b = e >> 12, c = e & 4095; float s = F.in[I_BADA][c];
#pragma unroll
        for (int ks = 0; ks < 16; ++ks) s += adap[(size_t)(ks * 3 + b) * NADA + c];
        ada[e] = s; }
    if (F.tid < 144) { const int e = F.bid * 144 + F.tid, b = e / NADA, c = e % NADA; float s = F.in[I_BADA][c];
#pragma unroll
        for (int ks = 0; ks < 16; ++ks) s += adap[(size_t)(ks * 3 + b) * NADA + c];
        ((float*)(F.ws + WS_ADA))[e] = s; }
    __syncthreads();
    for (int r = gw; r < MA; r += NGW) {
        const bool lat = r < M; const int b = lat ? (r >> 13) : 2, t = r & 8191;
        const float* xr = lat ? (F.in[I_X] + (size_t)r * D) : (F.in[I_CTX] + (size_t)(r - M) * D);
        f32x4 v[8]; float ss = 0.f;
#pragma unroll
        for (int j = 0; j < 8; ++j) { const int c = 4 * F.lane + 256 * j; v[j] = *(const f32x4*)(xr + c);
            if (lat) { const float* pp = (c < 1024) ? (TR + (size_t)(t >> 6) * 1024 + c) : (TC + (size_t)(t & 63) * 1024 + (c - 1024)); v[j] += *(const f32x4*)pp; }
            ss += (v[j][0] * v[j][0] + v[j][1] * v[j][1]) + (v[j][2] * v[j][2] + v[j][3] * v[j][3]); }
        const float rstd = 1.0f / sqrtf(wave_sum(ss) * (1.0f / D) + EPS);
        const LAS float* sh = ada + b * 4096; const LAS float* scl = sh + D;
#pragma unroll
        for (int j = 0; j < 8; ++j) { const int c = 4 * F.lane + 256 * j; const f32x4 g = *(const f32x4*)(F.in[I_NMIX] + c), s1 = *(const LAS f32x4*)(scl + c), s0 = *(const LAS f32x4*)(sh + c);
            const f32x4 o = (v[j] * rstd * g) * (1.0f + s1) + s0;
            v2u w; w.x = pk2(o[0], o[1]); w.y = pk2(o[2], o[3]); *(v2u*)(HA + (size_t)r * D + c) = w; }
    }
}
__device__ __forceinline__ void s5_naive(Frame& F, float* Yd  ) {
    if (F.wave != 0) return;
    const int unit = F.bid; if (unit >= 256) return;
    const int b = unit >> 7, d = (unit >> 6) & 1, g = unit & 63, p = F.lane;
    const float2 lam = ((const float2*)(F.ws + WS_LAMB))[(d * 64 + g) * 64 + p];
    const float2* BB = (const float2*)(F.ws + WS_BBAR) + (size_t)((d * 64 + g) * 64 + p) * SH;
    float2 Bb[16]; float Cr[16], Ci[16];
#pragma unroll
    for (int h = 0; h < 16; ++h) { Bb[h] = BB[h]; Cr[h] = F.in[I_CRE][(size_t)((d * 64 + g) * 16 + h) * 64 + p]; Ci[h] = F.in[I_CIM][(size_t)((d * 64 + g) * 16 + h) * 64 + p]; }
    const bf16* U = (const bf16*)(F.ws + WS_U);
    float sr = 0.f, si = 0.f;
    const int l5 = (F.lane >> 5) & 1, l4 = (F.lane >> 4) & 1, l3 = (F.lane >> 3) & 1, l2 = (F.lane >> 2) & 1;
    for (int step = 0; step < CTX + SEQ; ++step) {
        int row; const bool lat = step >= CTX;
        if (!lat) { const int tc = d == 0 ? step : (CTX - 1 - step); row = M + b * CTX + tc; }
        else { const int tl = step - CTX; const int t = d == 0 ? tl : (SEQ - 1 - tl); row = b * SEQ + t; }
        const v4u u0 = *(const v4u*)(U + (size_t)row * S5W + g * 16), u1 = *(const v4u*)(U + (size_t)row * S5W + g * 16 + 8);
        float uu[16];
        uu[0] = pg8::bf_lo(u0.x); uu[1] = pg8::bf_hi(u0.x); uu[2] = pg8::bf_lo(u0.y); uu[3] = pg8::bf_hi(u0.y); uu[4] = pg8::bf_lo(u0.z); uu[5] = pg8::bf_hi(u0.z); uu[6] = pg8::bf_lo(u0.w); uu[7] = pg8::bf_hi(u0.w);
        uu[8] = pg8::bf_lo(u1.x); uu[9] = pg8::bf_hi(u1.x); uu[10] = pg8::bf_lo(u1.y); uu[11] = pg8::bf_hi(u1.y); uu[12] = pg8::bf_lo(u1.z); uu[13] = pg8::bf_hi(u1.z); uu[14] = pg8::bf_lo(u1.w); uu[15] = pg8::bf_hi(u1.w);
        float br = 0.f, bi = 0.f;
#pragma unroll
        for (int h = 0; h < 16; ++h) { br += Bb[h].x * uu[h]; bi += Bb[h].y * uu[h]; }
        const float nr = lam.x * sr - lam.y * si + br, ni = lam.x * si + lam.y * sr + bi; sr = nr; si = ni;
        if (lat) {
            float v[16];
#pragma unroll
            for (int h = 0; h < 16; ++h) v[h] = Cr[h] * sr - Ci[h] * si;
            float w8[8], w4[4], w2[2], w1;
#pragma unroll
            for (int j = 0; j < 8; ++j) { const float keep = l5 ? v[j + 8] : v[j], send = l5 ? v[j] : v[j + 8]; w8[j] = keep + __shfl_xor(send, 32); }
#pragma unroll
            for (int j = 0; j < 4; ++j) { const float keep = l4 ? w8[j + 4] : w8[j], send = l4 ? w8[j] : w8[j + 4]; w4[j] = keep + __shfl_xor(send, 16); }
#pragma unroll
            for (int j = 0; j < 2; ++j) { const float keep = l3 ? w4[j + 2] : w4[j], send = l3 ? w4[j] : w4[j + 2]; w2[j] = keep + __shfl_xor(send, 8); }
            { const float keep = l2 ? w2[1] : w2[0], send = l2 ? w2[0] : w2[1]; w1 = keep + __shfl_xor(send, 4); }
            w1 += __shfl_xor(w1, 2); w1 += __shfl_xor(w1, 1);
            if ((F.lane & 3) == 0) Yd[((size_t)d * M + row) * S5W + g * 16 + (F.lane >> 2)] = w1;
        }
    }
}
__device__ __forceinline__ void s5_finalize_naive(Frame& F, const float* Yd) {
    const bf16* U = (const bf16*)(F.ws + WS_U); bf16* YG = (bf16*)(F.ws + WS_YG);
    const size_t n = (size_t)M * S5W;
    for (size_t i = (size_t)F.bid * NTHR + F.tid; i < n; i += (size_t)F.G * NTHR) {
        const int ch = (int)(i & 1023);
        const float y = Yd[i] + Yd[n + i] + bf2f(U[i]) * F.in[I_S5D][ch];
        YG[i] = (bf16)f2bf(gelu_tanh(y));
    }
}
__device__ __forceinline__ void taps_gen(Frame& F, float* TAPS) {
    const float* H2 = (const float*)(F.ws + WS_H2);
    for (int unit = F.bid; unit < 16 * 32 * 2; unit += F.G) {
        const int nc = unit & 15, cc = (unit >> 4) & 31, d = unit >> 9, n = nc * 512 + F.tid;
        float hrow[64];
#pragma unroll
        for (int k = 0; k < 64; k += 4) { const f32x4 q = *(const f32x4*)(H2 + (size_t)n * 64 + k); hrow[k] = q[0]; hrow[k + 1] = q[1]; hrow[k + 2] = q[2]; hrow[k + 3] = q[3]; }
        const float t = (float)n / 8191.0f;
        for (int ci = 0; ci < 32; ++ci) { const int c = cc * 32 + ci; float a = 0.f;
#pragma unroll
            for (int k = 0; k < 64; ++k) a += hrow[k] * F.in[I_F3W][(size_t)k * 2048 + d * 1024 + c];
            a *= __expf(-t * fabsf(F.in[I_DECAY][d * 1024 + c]));
            if (d == 0) TAPS[(size_t)c * 16384 + n] = a;
            else { if (n >= 1) TAPS[(size_t)c * 16384 + 16384 - n] = a; else TAPS[(size_t)c * 16384 + 8192] = 0.f; } }
    }
}
__device__ __forceinline__ float sconv3(const bf16* row, int t, float w0, float w1, float w2, float bb) {
    const float a = t > 0 ? bf2f(row[t - 1]) : 0.f, b = bf2f(row[t]), c = t < SEQ - 1 ? bf2f(row[t + 1]) : 0.f;
    return a * w0 + b * w1 + c * w2 + bb;
}
__device__ __forceinline__ void conv_naive(Frame& F, const float* TAPS) {
    LAS float* tp = (LAS float*)F.lds; LAS float* wv = tp + 16384;
    const bf16* HYT = (const bf16*)(F.ws + WS_HYT); bf16* HYB = (bf16*)(F.ws + WS_HYB);
    const float* cw = F.in[I_CONVW]; const float* cb = F.in[I_CONVB];
    for (int c = F.bid; c < HYW; c += F.G) {
        __syncthreads();
        for (int i = F.tid; i < 16384; i += NTHR) tp[i] = TAPS[(size_t)c * 16384 + i];
        const int c1 = 1024 + c, c2 = 2048 + c;
        for (int i = F.tid; i < 16384; i += NTHR) { const int b = i >> 13, t = i & 8191;
            const float x1 = sconv3(HYT + (size_t)c1 * M + b * SEQ, t, cw[c1], cw[3072 + c1], cw[6144 + c1], cb[c1]);
            const float vv = sconv3(HYT + (size_t)c2 * M + b * SEQ, t, cw[c2], cw[3072 + c2], cw[6144 + c2], cb[c2]);
            wv[i] = x1 * vv; }
        __syncthreads();
        float a0[16], a1[16];
#pragma unroll
        for (int i = 0; i < 16; ++i) { a0[i] = 0.f; a1[i] = 0.f; }
        for (int s = 0; s < SEQ; ++s) { const float w0 = wv[s], w1 = wv[8192 + s];
#pragma unroll
            for (int i = 0; i < 16; ++i) { const float tv = tp[(F.tid + 512 * i - s) & 16383]; a0[i] += tv * w0; a1[i] += tv * w1; } }
        const float hb = F.in[I_HBIAS][c];
#pragma unroll
        for (int i = 0; i < 16; ++i) { const int t = F.tid + 512 * i;
            const float x00 = sconv3(HYT + (size_t)c * M, t, cw[c], cw[3072 + c], cw[6144 + c], cb[c]);
            const float x01 = sconv3(HYT + (size_t)c * M + SEQ, t, cw[c], cw[3072 + c], cw[6144 + c], cb[c]);
            HYB[(size_t)t * HYW + c] = (bf16)f2bf(x00 * (a0[i] + hb * wv[t]));
            HYB[(size_t)(SEQ + t) * HYW + c] = (bf16)f2bf(x01 * (a1[i] + hb * wv[8192 + t])); }
    }
}
__device__ __forceinline__ void pn2_modulate(Frame& F) {
    const int gw = F.bid * NWAVES + F.wave, NGW = F.G * NWAVES;
    const float* ada = (const float*)(F.ws + WS_ADA); const float* rsq = (const float*)(F.ws + WS_RSQ1); bf16* HB = (bf16*)(F.ws + WS_A);
    for (int r = gw; r < M; r += NGW) {
        const int b = r >> 13;
        const float ss = wave_sum(F.lane < 32 ? rsq[(size_t)r * 32 + F.lane] : 0.f);
        const float rstd = 1.0f / sqrtf(ss * (1.0f / D) + EPS);
        const float* sh = ada + (size_t)b * NADA + 3 * D; const float* scl = sh + D;
        const float* xr = F.out + (size_t)r * D;
#pragma unroll
        for (int j = 0; j < 8; ++j) { const int c = 4 * F.lane + 256 * j; const f32x4 x = *(const f32x4*)(xr + c), g = *(const f32x4*)(F.in[I_NFFN] + c), s1 = *(const f32x4*)(scl + c), s0 = *(const f32x4*)(sh + c);
            const f32x4 o = (x * rstd * g) * (1.0f + s1) + s0;
            v2u w; w.x = pk2(o[0], o[1]); w.y = pk2(o[2], o[3]); *(v2u*)(HB + (size_t)r * D + c) = w; }
    }
}
__device__ __forceinline__ void pf3_final(Frame& F) {
    const int gw = F.bid * NWAVES + F.wave, NGW = F.G * NWAVES;
    const float* rsq = (const float*)(F.ws + WS_RSQ2);
    for (int r = gw; r < M; r += NGW) {
        const float ss = wave_sum(F.lane < 32 ? rsq[(size_t)r * 32 + F.lane] : 0.f);
        const float rstd = 1.0f / sqrtf(ss * (1.0f / D) + EPS);
        float* xr = F.out + (size_t)r * D;
#pragma unroll
        for (int j = 0; j < 8; ++j) { const int c = 4 * F.lane + 256 * j; const f32x4 x = *(const f32x4*)(xr + c), g = *(const f32x4*)(F.in[I_NF] + c);
            *(f32x4*)(xr + c) = x * rstd * g; }
    }
}
#ifndef N_PHASES
#define N_PHASES 13
#endif
__global__ void __launch_bounds__(NTHR, 2) mega(Args args) {
    extern __shared__ __attribute__((aligned(16))) unsigned char lds_raw[];
    Frame F;
    F.lds = (LAS unsigned char*)lds_raw;
    F.tid = threadIdx.x; F.lane = F.tid & 63; F.wave = __builtin_amdgcn_readfirstlane(F.tid >> 6);
    F.bid = blockIdx.x; F.G = gridDim.x;
#pragma unroll
    for (int i = 0; i < 34; ++i) F.in[i] = args.in[i];
    F.out = args.out; F.ws = args.ws;
    const int lo = args.ph_lo, hi = args.ph_hi;
    cg::grid_group grid = cg::this_grid();
#define IN(k) (lo <= (k) && (k) < hi)
#define SEAM(k) do { if (IN(k) && IN((k) + 1)) grid.sync(); } while (0)
    unsigned char* ws = F.ws;
    typedef pg8::bf16_t pb;
    if (IN(0)) { p0_prologue(F); } SEAM(0);
    if (IN(1)) { p1_modulate(F); } SEAM(1);
    if (IN(2)) {
        { pg8::Gemm g{(const pb*)(ws + WS_A), (const pb*)(ws + WS_WIN), MA, S5W, D}; pg8::StaticOrder S; S.init(MA, S5W, F.G, F.bid);
          pg8::EpiStoreBf16 E{(pb*)(ws + WS_U), S5W}; pg8::gemm_phase<pg8::EpiStoreBf16, pg8::StaticOrder, true, true>(F.lds, g, S, E); }
        { pg8::Gemm g{(const pb*)(ws + WS_WIN) + (size_t)S5W * D, (const pb*)(ws + WS_A), 3 * HYW, M, D}; pg8::StaticOrder S; S.init(3 * HYW, M, F.G, F.bid);
          pg8::EpiStoreBf16 E{(pb*)(ws + WS_HYT), M}; pg8::gemm_phase<pg8::EpiStoreBf16, pg8::StaticOrder, true, true>(F.lds, g, S, E); }
        { pg8::Gemm g{(const pb*)(ws + WS_A), (const pb*)(ws + WS_WIN) + (size_t)(S5W + 3 * HYW) * D, M, 2 * D, D}; pg8::StaticOrder S; S.init(M, 2 * D, F.G, F.bid);
          pg8::EpiStoreBf16 E{(pb*)(ws + WS_GATES), 2 * D}; pg8::gemm_phase<pg8::EpiStoreBf16, pg8::StaticOrder, true, true>(F.lds, g, S, E); }
    } SEAM(2);
    if (IN(3)) { taps_gen(F, (float*)(ws + WS_A)); s5_naive(F, F.out); } SEAM(3);
    if (IN(4)) { conv_naive(F, (const float*)(ws + WS_A)); } SEAM(4);
    if (IN(5)) {
        s5_finalize_naive(F, F.out);
        pg8::Gemm g{(const pb*)(ws + WS_HYB), (const pb*)(ws + WS_WHY), M, D, HYW}; pg8::StaticOrder S; S.init(M, D, F.G, F.bid);
        pg8::EpiHyOut E{(pb*)(ws + WS_A), (const pb*)(ws + WS_GATES)}; pg8::gemm_phase<pg8::EpiHyOut, pg8::StaticOrder, true, true>(F.lds, g, S, E);
    } SEAM(5);
    if (IN(6)) {
        pg8::Gemm g{(const pb*)(ws + WS_YG), (const pb*)(ws + WS_WGLU), M, 2 * D, S5W}; pg8::StaticOrder S; S.init(M, 2 * D, F.G, F.bid);
        pg8::EpiGlu E{(pb*)(ws + WS_MERGED), (const pb*)(ws + WS_GATES), (const pb*)(ws + WS_A)}; pg8::gemm_phase<pg8::EpiGlu, pg8::StaticOrder, true, true>(F.lds, g, S, E);
    } SEAM(6);
    if (IN(7)) {
        pg8::Gemm g{(const pb*)(ws + WS_MERGED), (const pb*)(ws + WS_WOUT), M, D, D}; pg8::StaticOrder S; S.init(M, D, F.G, F.bid);
        pg8::EpiRes E{F.in[I_X], F.out, (const float*)(ws + WS_ADA) + 2 * D, NADA, (const float*)(ws + WS_TR), (const float*)(ws + WS_TC), (float*)(ws + WS_RSQ1)};
        pg8::gemm_phase<pg8::EpiRes, pg8::StaticOrder, true, true>(F.lds, g, S, E);
    } SEAM(7);
    if (IN(8)) { pn2_modulate(F); } SEAM(8);
    if (IN(9)) {
        pg8::Gemm g{(const pb*)(ws + WS_A), (const pb*)(ws + WS_WF1), M, 2 * DFF, D}; pg8::StaticOrder S; S.init(M, 2 * DFF, F.G, F.bid);
        pg8::EpiSwiglu E{(pb*)(ws + WS_GATES)}; pg8::gemm_phase<pg8::EpiSwiglu, pg8::StaticOrder, true, true>(F.lds, g, S, E);
    } SEAM(9);
    if (IN(10)) {
        pg8::Gemm g{(const pb*)(ws + WS_GATES), (const pb*)(ws + WS_WF2), M, D, DFF}; pg8::StaticOrder S; S.init(M, D, F.G, F.bid);
        pg8::EpiRes E{F.out, F.out, (const float*)(ws + WS_ADA) + 5 * D, NADA, nullptr, nullptr, (float*)(ws + WS_RSQ2)};
        pg8::gemm_phase<pg8::EpiRes, pg8::StaticOrder, true, true>(F.lds, g, S, E);
    } SEAM(10);
    if (IN(11)) { pf3_final(F); }
#undef IN
#undef SEAM
}

#ifndef MK_ONE_LAUNCH
#define MK_ONE_LAUNCH 0
#endif
extern "C" void kernel_launch(void* const* d_in, const int* in_sizes, int n_in, void* d_out, int out_size, void* d_ws, size_t ws_size, hipStream_t stream) {
    static int grid = 0;
    if (grid == 0) {
        if (n_in != 34 || out_size != M * D || ws_size < WS_END) { fprintf(stderr, "kernel_launch: unexpected shapes n_in %d out %d ws %zu\n", n_in, out_size, ws_size); grid = -1; return; }
        int dev = 0, cus = 0, per_cu = 0;
        (void)hipGetDevice(&dev); (void)hipDeviceGetAttribute(&cus, hipDeviceAttributeMultiprocessorCount, dev);
        (void)hipFuncSetAttribute((const void*)mega, hipFuncAttributeMaxDynamicSharedMemorySize, LDS_BYTES);
        (void)hipOccupancyMaxActiveBlocksPerMultiprocessor(&per_cu, (const void*)mega, NTHR, LDS_BYTES);
        (void)hipGetLastError();
        grid = cus * (per_cu >= 1 ? 1 : 0);
        if (grid != 256) fprintf(stderr, "kernel_launch: grid %d (cus %d per_cu %d)\n", grid, cus, per_cu);
        if (grid <= 0) { grid = -1; return; }
    }
    if (grid < 0) return;
    Args a{};
    for (int i = 0; i < 34; ++i) a.in[i] = (const float*)d_in[i];
    a.out = (float*)d_out; a.ws = (unsigned char*)d_ws;
#if MK_ONE_LAUNCH
    a.ph_lo = 0; a.ph_hi = N_PHASES;
    void* kargs[] = {&a};
    hipError_t e = hipLaunchCooperativeKernel((const void*)mega, dim3(grid), dim3(NTHR), kargs, LDS_BYTES, stream);
    if (e != hipSuccess) fprintf(stderr, "cooperative launch failed: %s (grid %d)\n", hipGetErrorString(e), grid);
#else
    for (int ph = 0; ph < 12; ++ph) { a.ph_lo = ph; a.ph_hi = ph + 1; hipLaunchKernelGGL(mega, dim3(grid), dim3(NTHR), LDS_BYTES, stream, a); }
#endif
}
```

```cpp
#include <hip/hip_runtime.h>
#include <hip/hip_cooperative_groups.h>
#include <cstdio>
#include <cstdint>
namespace cg = cooperative_groups;
namespace pg8 {
#define PG8_LAS __attribute__((address_space(3)))
typedef unsigned short bf16_t;
typedef short bf16x8 __attribute__((ext_vector_type(8)));
typedef float f32x4 __attribute__((ext_vector_type(4)));
typedef unsigned u32x4 __attribute__((ext_vector_type(4)));
constexpr int BM = 256, BK = 64, HALF = 128, HTB = HALF * BK * 2  , STAGE_BYTES = 8 * HTB, NXCD = 8, WGM = 8;

__host__ __device__ __forceinline__ int lds_byte(int r, int c) { const int st = (r >> 4) * 2 + (c >> 5), rr = r & 15, cc = c & 31, ob = rr * 64 + cc * 2; return st * 1024 + (ob ^ (((ob >> 9) & 1) << 5)); }
__host__ __device__ __forceinline__ void stage_rc(int b, int& R, int& C) { const int st = b / 1024, sb = b % 1024, swz = sb ^ (((sb >> 9) & 1) << 5); R = (st >> 1) * 16 + swz / 64; C = (st & 1) * 32 + (swz % 64) / 2; }
__host__ __device__ __forceinline__ int perm32(int rho) { const int n = rho >> 4, i = rho & 15; return 8 * (i >> 2) + 4 * n + (i & 3); }

struct Unit { int pm, pn; };
struct Gemm { const bf16_t* A; const bf16_t* Bt; int M, N, K, lda, ldb; };

struct StaticOrder {
    int nM, nN, nwg, G, c;
    __host__ __device__ void init(int M, int N, int G_, int c_) { nM = M / BM; nN = N / BM; nwg = nM * nN; G = G_; c = c_; }
    __host__ __device__ bool next(int i, Unit& u) const {
        const long L = (long)i * G + c; if (L >= nwg) return false;
        int wgid = (int)L; { const int q = nwg / NXCD, r = nwg % NXCD, xcd = wgid % NXCD, off = wgid / NXCD; wgid = (xcd < r ? xcd * (q + 1) : r * (q + 1) + (xcd - r) * q) + off; }
        const int nig = WGM * nN, gid = wgid / nig, fm = gid * WGM, gsz = (nM - fm) < WGM ? (nM - fm) : WGM;
        u.pm = fm + ((wgid % nig) % gsz); u.pn = (wgid % nig) / gsz; return true;
    }
    __device__ __forceinline__ void a_ready(const Unit&) const {}
    __device__ __forceinline__ void done(const Unit&) const {}
};
__device__ __forceinline__ unsigned cvt_pk_bf16(float lo, float hi) { unsigned r; asm volatile("v_cvt_pk_bf16_f32 %0, %1, %2" : "=v"(r) : "v"(lo), "v"(hi)); return r; }
typedef float f32x2 __attribute__((ext_vector_type(2)));
typedef unsigned u32x2 __attribute__((ext_vector_type(2)));
__device__ __forceinline__ float bf_lo(unsigned w) { return __uint_as_float(w << 16); }
__device__ __forceinline__ float bf_hi(unsigned w) { return __uint_as_float(w & 0xffff0000u); }
__device__ __forceinline__ float sigm(float x) { return 1.0f / (1.0f + __expf(-x)); }
__device__ __forceinline__ float gelu_t(float y) { const float z = 0.7978845608028654f * (y + 0.044715f * y * y * y); const float e = __expf(2.0f * z); return y * (1.0f - 1.0f / (e + 1.0f)); }

struct EpiStoreBf16 {
    static constexpr bool PERM = true, AFTER_DRAIN = false;
    bf16_t* O; int ldc;
    __device__ __forceinline__ void operator()(const f32x4 (&acc)[2][2][4][2], const Unit& u, int wr, int wc, int fr, int fq) const {
        const int row0 = u.pm * BM + wr * 64 + fr, col0 = u.pn * BM + wc * 32 + 8 * fq;
#pragma unroll
        for (int ai = 0; ai < 2; ++ai)
#pragma unroll
            for (int m = 0; m < 4; ++m) { bf16_t* rowp = O + (size_t)(row0 + ai * HALF + m * 16) * ldc + col0;
#pragma unroll
                for (int bj = 0; bj < 2; ++bj) { const f32x4 v0 = acc[ai][bj][m][0], v1 = acc[ai][bj][m][1];
                    u32x4 w; w.x = cvt_pk_bf16(v0[0], v0[1]); w.y = cvt_pk_bf16(v0[2], v0[3]); w.z = cvt_pk_bf16(v1[0], v1[1]); w.w = cvt_pk_bf16(v1[2], v1[3]);
                    *(u32x4*)(rowp + bj * HALF) = w; } }
    }
};
struct EpiHyOut {
    static constexpr bool PERM = true, AFTER_DRAIN = false;
    bf16_t* O; const bf16_t* gates;
    __device__ __forceinline__ void operator()(const f32x4 (&acc)[2][2][4][2], const Unit& u, int wr, int wc, int fr, int fq) const {
        const int row0 = u.pm * BM + wr * 64 + fr, col0 = u.pn * BM + wc * 32 + 8 * fq;
#pragma unroll
        for (int ai = 0; ai < 2; ++ai)
#pragma unroll
            for (int m = 0; m < 4; ++m) { const size_t row = (size_t)(row0 + ai * HALF + m * 16);
#pragma unroll
                for (int bj = 0; bj < 2; ++bj) { const f32x4 v0 = acc[ai][bj][m][0], v1 = acc[ai][bj][m][1];
                    const u32x4 g = *(const u32x4*)(gates + row * 4096 + 2048 + col0 + bj * HALF);
                    u32x4 w; w.x = cvt_pk_bf16(v0[0] * sigm(bf_lo(g.x)), v0[1] * sigm(bf_hi(g.x))); w.y = cvt_pk_bf16(v0[2] * sigm(bf_lo(g.y)), v0[3] * sigm(bf_hi(g.y)));
                    w.z = cvt_pk_bf16(v1[0] * sigm(bf_lo(g.z)), v1[1] * sigm(bf_hi(g.z))); w.w = cvt_pk_bf16(v1[2] * sigm(bf_lo(g.w)), v1[3] * sigm(bf_hi(g.w)));
                    *(u32x4*)(O + row * 2048 + col0 + bj * HALF) = w; } }
    }
};
struct EpiGlu {
    static constexpr bool PERM = true, AFTER_DRAIN = false;
    bf16_t* O; const bf16_t* gates; const bf16_t* mhy;
    __device__ __forceinline__ void operator()(const f32x4 (&acc)[2][2][4][2], const Unit& u, int wr, int wc, int fr, int fq) const {
        const int row0 = u.pm * BM + wr * 64 + fr, j0 = (u.pn * BM + wc * 32 + 8 * fq) >> 1;
#pragma unroll
        for (int ai = 0; ai < 2; ++ai)
#pragma unroll
            for (int m = 0; m < 4; ++m) { const size_t row = (size_t)(row0 + ai * HALF + m * 16);
#pragma unroll
                for (int bj = 0; bj < 2; ++bj) { const f32x4 v = acc[ai][bj][m][0], g = acc[ai][bj][m][1]; const int j = j0 + bj * 64;
                    const u32x2 gs = *(const u32x2*)(gates + row * 4096 + j); const u32x2 mh = *(const u32x2*)(mhy + row * 2048 + j);
                    const float o0 = sigm(bf_lo(gs.x)) * v[0] * sigm(g[0]) + bf_lo(mh.x), o1 = sigm(bf_hi(gs.x)) * v[1] * sigm(g[1]) + bf_hi(mh.x);
                    const float o2 = sigm(bf_lo(gs.y)) * v[2] * sigm(g[2]) + bf_lo(mh.y), o3 = sigm(bf_hi(gs.y)) * v[3] * sigm(g[3]) + bf_hi(mh.y);
                    u32x2 w; w.x = cvt_pk_bf16(o0, o1); w.y = cvt_pk_bf16(o2, o3);
                    *(u32x2*)(O + row * 2048 + j) = w; } }
    }
};
struct EpiSwiglu {
    static constexpr bool PERM = true, AFTER_DRAIN = false;
    bf16_t* O;
    __device__ __forceinline__ void operator()(const f32x4 (&acc)[2][2][4][2], const Unit& u, int wr, int wc, int fr, int fq) const {
        const int row0 = u.pm * BM + wr * 64 + fr, j0 = (u.pn * BM + wc * 32 + 8 * fq) >> 1;
#pragma unroll
        for (int ai = 0; ai < 2; ++ai)
#pragma unroll
            for (int m = 0; m < 4; ++m) { const size_t row = (size_t)(row0 + ai * HALF + m * 16);
#pragma unroll
                for (int bj = 0; bj < 2; ++bj) { const f32x4 a = acc[ai][bj][m][0], b = acc[ai][bj][m][1]; const int j = j0 + bj * 64;
                    u32x2 w; w.x = cvt_pk_bf16(a[0] * sigm(a[0]) * b[0], a[1] * sigm(a[1]) * b[1]); w.y = cvt_pk_bf16(a[2] * sigm(a[2]) * b[2], a[3] * sigm(a[3]) * b[3]);
                    *(u32x2*)(O + row * 5632 + j) = w; } }
    }
};
struct EpiRes {
    static constexpr bool PERM = false, AFTER_DRAIN = false;
    const float* base; float* out; const float* gate  ; int ldg; const float* TR; const float* TC; float* rsq;
    __device__ __forceinline__ void operator()(const f32x4 (&acc)[2][2][4][2], const Unit& u, int wr, int wc, int fr, int fq) const {
        const int row0 = u.pm * BM + wr * 64 + fr, col0 = u.pn * BM + wc * 32 + 4 * fq;
        const int b = (u.pm * BM) >> 13;
        f32x4 gv[2][2];
#pragma unroll
        for (int bj = 0; bj < 2; ++bj)
#pragma unroll
            for (int n = 0; n < 2; ++n) gv[bj][n] = *(const f32x4*)(gate + (size_t)b * ldg + col0 + bj * HALF + n * 16);
#pragma unroll
        for (int ai = 0; ai < 2; ++ai)
#pragma unroll
            for (int m = 0; m < 4; ++m) { const int row = row0 + ai * HALF + m * 16; const size_t off = (size_t)row * 2048 + col0; float ss = 0.f;
                const float* pp = nullptr;
                if (TR) { const int t = row & 8191; pp = (col0 < 1024) ? (TR + (size_t)(t >> 6) * 1024 + col0) : (TC + (size_t)(t & 63) * 1024 + (col0 - 1024)); }
#pragma unroll
                for (int bj = 0; bj < 2; ++bj)
#pragma unroll
                    for (int n = 0; n < 2; ++n) { f32x4 bs = *(const f32x4*)(base + off + bj * HALF + n * 16);
                        if (TR) bs += *(const f32x4*)(pp + bj * HALF + n * 16);
                        const f32x4 o = bs + gv[bj][n] * acc[ai][bj][m][n];
                        ss += (o[0] * o[0] + o[1] * o[1]) + (o[2] * o[2] + o[3] * o[3]);
                        *(f32x4*)(out + off + bj * HALF + n * 16) = o; }
                ss += __shfl_xor(ss, 16); ss += __shfl_xor(ss, 32);
                if (fq == 0) rsq[(size_t)row * 32 + u.pn * 4 + wc] = ss; }
    }
};
struct EpiU {
    static constexpr bool PERM = true, AFTER_DRAIN = false;
    bf16_t* A2; bf16_t* UCTX;
    __device__ __forceinline__ void operator()(const f32x4 (&acc)[2][2][4][2], const Unit& u, int wr, int wc, int fr, int fq) const {
        const int row0 = u.pm * BM + wr * 64 + fr, col0 = u.pn * BM + wc * 32 + 8 * fq;
#pragma unroll
        for (int ai = 0; ai < 2; ++ai)
#pragma unroll
            for (int m = 0; m < 4; ++m) { const int row = row0 + ai * HALF + m * 16;
#pragma unroll
                for (int bj = 0; bj < 2; ++bj) { const f32x4 v0 = acc[ai][bj][m][0], v1 = acc[ai][bj][m][1]; const int col = col0 + bj * HALF;
                    u32x4 w; w.x = cvt_pk_bf16(v0[0], v0[1]); w.y = cvt_pk_bf16(v0[2], v0[3]); w.z = cvt_pk_bf16(v1[0], v1[1]); w.w = cvt_pk_bf16(v1[2], v1[3]);
                    if (u.pm < 64) { const int t = row & 8191, b = row >> 13, g = col >> 4, h0 = col & 15;
                        *(u32x4*)(A2 + ((size_t)(g * 1024 + b * 512 + (t >> 4)) * 512 + 256 + (t & 15) * 16 + h0)) = w; }
                    else *(u32x4*)(UCTX + (size_t)(row - 16384) * 1024 + col) = w; } }
    }
};
struct EpiSloc {
    static constexpr bool PERM = false, AFTER_DRAIN = false;
    float* S;
    __device__ __forceinline__ void operator()(const f32x4 (&acc)[2][2][4][2], const Unit& u, int wr, int wc, int fr, int fq) const {
        const int row0 = u.pm * BM + wr * 64 + fr, col0 = wc * 32 + 4 * fq;
#pragma unroll
        for (int ai = 0; ai < 2; ++ai)
#pragma unroll
            for (int m = 0; m < 4; ++m) { float* rowp = S + (size_t)(row0 + ai * HALF + m * 16) * 256 + col0;
#pragma unroll
                for (int bj = 0; bj < 2; ++bj)
#pragma unroll
                    for (int n = 0; n < 2; ++n) *(f32x4*)(rowp + bj * HALF + n * 16) = acc[ai][bj][m][n]; }
    }
};
struct EpiYg {
    static constexpr bool PERM = true, AFTER_DRAIN = false;
    bf16_t* YG; const bf16_t* A2; const float* Dskip;
    __device__ __forceinline__ void operator()(const f32x4 (&acc)[2][2][4][2], const Unit& u, int wr, int wc, int fr, int fq) const {
        const int row0 = u.pm * BM + wr * 64 + fr, col0 = wc * 32 + 8 * fq;
#pragma unroll
        for (int ai = 0; ai < 2; ++ai)
#pragma unroll
            for (int m = 0; m < 4; ++m) { const int R = row0 + ai * HALF + m * 16, g = R >> 10, b = (R >> 9) & 1, c = R & 511;
#pragma unroll
                for (int bj = 0; bj < 2; ++bj) { const f32x4 v0 = acc[ai][bj][m][0], v1 = acc[ai][bj][m][1]; const int col = col0 + bj * HALF, i = col >> 4, h0 = col & 15;
                    const u32x4 uu = *(const u32x4*)(A2 + (size_t)R * 512 + 256 + col);
                    const f32x4 d0 = *(const f32x4*)(Dskip + g * 16 + h0), d1 = *(const f32x4*)(Dskip + g * 16 + h0 + 4);
                    const float y0 = v0[0] + bf_lo(uu.x) * d0[0], y1 = v0[1] + bf_hi(uu.x) * d0[1], y2 = v0[2] + bf_lo(uu.y) * d0[2], y3 = v0[3] + bf_hi(uu.y) * d0[3];
                    const float y4 = v1[0] + bf_lo(uu.z) * d1[0], y5 = v1[1] + bf_hi(uu.z) * d1[1], y6 = v1[2] + bf_lo(uu.w) * d1[2], y7 = v1[3] + bf_hi(uu.w) * d1[3];
                    u32x4 w; w.x = cvt_pk_bf16(gelu_t(y0), gelu_t(y1)); w.y = cvt_pk_bf16(gelu_t(y2), gelu_t(y3)); w.z = cvt_pk_bf16(gelu_t(y4), gelu_t(y5)); w.w = cvt_pk_bf16(gelu_t(y6), gelu_t(y7));
                    *(u32x4*)(YG + (size_t)(b * 8192 + c * 16 + i) * 1024 + g * 16 + h0) = w; } }
    }
};
struct BlockDiagOrder {
    int c;
    __device__ __forceinline__ bool next(int i, Unit& u) const { if (i != 0 || c >= 256) return false; u.pm = c; u.pn = c >> 2; return true; }
    __device__ __forceinline__ void a_ready(const Unit&) const {}
    __device__ __forceinline__ void done(const Unit&) const {}
};
template <class Epi, class Sched, bool ALIGN_EPI = false, bool SP2 = false>
__device__ __forceinline__ void gemm_phase(PG8_LAS unsigned char* lds, const Gemm g, const Sched& S, const Epi& E) {
    const int tid = threadIdx.x, wid = __builtin_amdgcn_readfirstlane(tid >> 6), lane = tid & 63, wr = wid >> 2, wc = wid & 3, fr = lane & 15, fq = lane >> 4;
    const int K = g.K, nt = K / BK, lda = g.lda ? g.lda : K, ldb = g.ldb ? g.ldb : K;
    unsigned voffA[2], voffB[2];
#pragma unroll
    for (int i = 0; i < 2; ++i) { int R, C; stage_rc(tid * 16 + i * 8192, R, C); const int Rb = Epi::PERM ? ((R & ~31) + perm32(R & 31)) : R;
        voffA[i] = (unsigned)(R * lda + C) * 2u; voffB[i] = (unsigned)(Rb * ldb + C) * 2u; }
    const size_t kstep = (size_t)(BK * 2);
    const size_t hstepA = (size_t)HALF * lda * 2, hstepB = (size_t)HALF * ldb * 2;
    const size_t tstepA = 2 * hstepA, tstepB = 2 * hstepB;
    const unsigned ldsw = (unsigned)wid * 1024u;
    const int aoff = lds_byte(wr * 64 + fr, fq * 8), boff = lds_byte(wc * 32 + fr, fq * 8);
#define PG8_SA(b, h) (((b) * 2 + (h)) * HTB)
#define PG8_SB(b, h) ((4 + (b) * 2 + (h)) * HTB)
#define PG8_STAGE(bufoff, gbase, voff) do { _Pragma("unroll") for (int _i = 0; _i < 2; ++_i) \
        __builtin_amdgcn_global_load_lds((const unsigned*)((const char*)(gbase) + (voff)[_i]), (PG8_LAS unsigned*)(lds + (bufoff) + ldsw + _i * 8192), 16, 0, 0); } while (0)
#define PG8_LDA(dst, b, h) do { _Pragma("unroll") for (int m = 0; m < 4; ++m) _Pragma("unroll") for (int k = 0; k < 2; ++k) dst[m][k] = *(const PG8_LAS bf16x8*)(lds + PG8_SA(b, h) + aoff + m * 2048 + k * 1024); } while (0)
#define PG8_LDB(dst, b, h) do { _Pragma("unroll") for (int n = 0; n < 2; ++n) _Pragma("unroll") for (int k = 0; k < 2; ++k) dst[n][k] = *(const PG8_LAS bf16x8*)(lds + PG8_SB(b, h) + boff + n * 2048 + k * 1024); } while (0)
#define PG8_MMA(ai, bj, At, Bt) do { __builtin_amdgcn_s_setprio(1); _Pragma("unroll") for (int m = 0; m < 4; ++m) _Pragma("unroll") for (int n = 0; n < 2; ++n) _Pragma("unroll") for (int k = 0; k < 2; ++k) \
        acc[ai][bj][m][n] = __builtin_amdgcn_mfma_f32_16x16x32_bf16(Bt[n][k], At[m][k], acc[ai][bj][m][n], 0, 0, 0); __builtin_amdgcn_s_setprio(0); } while (0)
#define PG8_WAIT_V(n) asm volatile("s_waitcnt vmcnt(" #n ")" ::: "memory")
#define PG8_WAIT_L(n) asm volatile("s_waitcnt lgkmcnt(" #n ")" ::: "memory")
#define PG8_BAR __builtin_amdgcn_s_barrier()
#define PG8_SCHED __builtin_amdgcn_sched_barrier(0)
    Unit cur, nxt; int ui = 0;
    if (!S.next(0, cur)) return;
    f32x4 acc[2][2][4][2];
#pragma unroll
    for (int a = 0; a < 2; ++a)
#pragma unroll
        for (int b = 0; b < 2; ++b)
#pragma unroll
            for (int m = 0; m < 4; ++m)
#pragma unroll
                for (int n = 0; n < 2; ++n) acc[a][b][m][n] = (f32x4){0.f, 0.f, 0.f, 0.f};
    bf16x8 At[4][2], B0[2][2], B1[2][2];
    const char* cA = (const char*)g.A + (size_t)cur.pm * tstepA; const char* cB = (const char*)g.Bt + (size_t)cur.pn * tstepB;
    S.a_ready(cur);
    if constexpr (SP2) {
        PG8_STAGE(PG8_SB(0, 0), cB, voffB); PG8_STAGE(PG8_SB(0, 1), cB + hstepB, voffB); PG8_STAGE(PG8_SA(0, 0), cA, voffA); PG8_STAGE(PG8_SA(0, 1), cA + hstepA, voffA);
        if (wr == 1) PG8_BAR;
        PG8_WAIT_V(2); PG8_BAR;
        PG8_STAGE(PG8_SB(1, 0), cB + kstep, voffB); PG8_STAGE(PG8_SA(1, 0), cA + kstep, voffA); PG8_STAGE(PG8_SB(1, 1), cB + hstepB + kstep, voffB);
        PG8_WAIT_V(6); PG8_BAR;
    } else {
        PG8_STAGE(PG8_SB(0, 0), cB, voffB); PG8_STAGE(PG8_SA(0, 0), cA, voffA); PG8_STAGE(PG8_SB(0, 1), cB + hstepB, voffB); PG8_STAGE(PG8_SA(0, 1), cA + hstepA, voffA);
        if (wr == 1) PG8_BAR;
        PG8_WAIT_V(4); PG8_BAR;
        PG8_STAGE(PG8_SB(1, 0), cB + kstep, voffB); PG8_STAGE(PG8_SA(1, 0), cA + kstep, voffA); PG8_STAGE(PG8_SB(1, 1), cB + hstepB + kstep, voffB);
        PG8_WAIT_V(6); PG8_BAR;
    }
    for (;;) {
        const bool has_next = S.next(ui + 1, nxt);
        const char* nA = has_next ? (const char*)g.A + (size_t)nxt.pm * tstepA : cA; const char* nB = has_next ? (const char*)g.Bt + (size_t)nxt.pn * tstepB : cB;
        for (int t = 0; t < nt; t += 2) {
            const bool last = (t == nt - 2);
            const char* a1 = cA + (size_t)(t + 1) * kstep;
            const char* a2 = last ? nA : cA + (size_t)(t + 2) * kstep; const char* b2 = last ? nB : cB + (size_t)(t + 2) * kstep;
            const char* a3 = a2 + kstep; const char* b3 = b2 + kstep;
            if (last && has_next) S.a_ready(nxt);
            if constexpr (SP2) {
            PG8_LDB(B0, 0, 0); PG8_LDB(B1, 0, 1); PG8_SCHED; PG8_LDA(At, 0, 0); PG8_STAGE(PG8_SA(1, 1), a1 + hstepA, voffA);
            PG8_WAIT_V(8); PG8_WAIT_L(0); PG8_BAR; PG8_MMA(0, 0, At, B0); PG8_MMA(0, 1, At, B1); PG8_BAR; PG8_SCHED;
            PG8_LDA(At, 0, 1); PG8_STAGE(PG8_SB(0, 0), b2, voffB); PG8_STAGE(PG8_SB(0, 1), b2 + hstepB, voffB); PG8_STAGE(PG8_SA(0, 0), a2, voffA);
            PG8_WAIT_V(8); PG8_WAIT_L(0); PG8_BAR; PG8_MMA(1, 0, At, B0); PG8_MMA(1, 1, At, B1); PG8_BAR; PG8_SCHED;
            PG8_LDB(B0, 1, 0); PG8_LDB(B1, 1, 1); PG8_SCHED; PG8_LDA(At, 1, 0); PG8_STAGE(PG8_SA(0, 1), a2 + hstepA, voffA);
            PG8_WAIT_V(8); PG8_WAIT_L(0); PG8_BAR; PG8_MMA(0, 0, At, B0); PG8_MMA(0, 1, At, B1); PG8_BAR; PG8_SCHED;
            PG8_LDA(At, 1, 1); PG8_STAGE(PG8_SB(1, 0), b3, voffB); PG8_STAGE(PG8_SB(1, 1), b3 + hstepB, voffB); PG8_STAGE(PG8_SA(1, 0), a3, voffA);
            PG8_WAIT_V(8); PG8_WAIT_L(0); PG8_BAR; PG8_MMA(1, 0, At, B0); PG8_MMA(1, 1, At, B1); PG8_BAR; PG8_SCHED;
            } else {
            PG8_LDB(B0, 0, 0); PG8_SCHED; PG8_LDA(At, 0, 0); PG8_STAGE(PG8_SA(1, 1), a1 + hstepA, voffA);
            PG8_WAIT_L(8); PG8_BAR; PG8_WAIT_L(0); PG8_MMA(0, 0, At, B0); PG8_BAR; PG8_SCHED;
            PG8_LDB(B1, 0, 1); PG8_STAGE(PG8_SB(0, 0), b2, voffB);
            PG8_BAR; PG8_WAIT_L(0); PG8_MMA(0, 1, At, B1); PG8_BAR;
            PG8_LDA(At, 0, 1); PG8_STAGE(PG8_SA(0, 0), a2, voffA);
            PG8_BAR; PG8_WAIT_L(0); PG8_MMA(1, 0, At, B0); PG8_BAR; PG8_SCHED;
            PG8_STAGE(PG8_SB(0, 1), b2 + hstepB, voffB);
            PG8_WAIT_V(6); PG8_BAR; PG8_MMA(1, 1, At, B1); PG8_BAR;
            PG8_LDB(B0, 1, 0); PG8_SCHED; PG8_LDA(At, 1, 0); PG8_STAGE(PG8_SA(0, 1), a2 + hstepA, voffA);
            PG8_WAIT_L(8); PG8_BAR; PG8_WAIT_L(0); PG8_MMA(0, 0, At, B0); PG8_BAR; PG8_SCHED;
            PG8_LDB(B1, 1, 1); PG8_STAGE(PG8_SB(1, 0), b3, voffB);
            PG8_BAR; PG8_WAIT_L(0); PG8_MMA(0, 1, At, B1); PG8_BAR;
            PG8_LDA(At, 1, 1); PG8_STAGE(PG8_SA(1, 0), a3, voffA);
            PG8_BAR; PG8_WAIT_L(0); PG8_MMA(1, 0, At, B0); PG8_BAR; PG8_SCHED;
            PG8_STAGE(PG8_SB(1, 1), b3 + hstepB, voffB);
            PG8_WAIT_V(6); PG8_BAR; PG8_MMA(1, 1, At, B1); PG8_BAR;
            }
        }
        if constexpr (ALIGN_EPI) { if (wr == 0) PG8_BAR; }
        if constexpr (!Epi::AFTER_DRAIN) { E(acc, cur, wr, wc, fr, fq); S.done(cur); }
        if (!has_next) break;
#pragma unroll
        for (int a = 0; a < 2; ++a)
#pragma unroll
            for (int b = 0; b < 2; ++b)
#pragma unroll
                for (int m = 0; m < 4; ++m)
#pragma unroll
                    for (int n = 0; n < 2; ++n) acc[a][b][m][n] = (f32x4){0.f, 0.f, 0.f, 0.f};
        cur = nxt; cA = nA; cB = nB; ++ui;
        if constexpr (ALIGN_EPI) { if (wr == 1) PG8_BAR; }
    }
    PG8_WAIT_V(0);
    if constexpr (!ALIGN_EPI) { if (wr == 0) PG8_BAR; }
    PG8_BAR;
    if constexpr (Epi::AFTER_DRAIN) { E.fused(acc, cur, wr, wc, fr, fq, lds, wid, lane); S.done(cur); }
#undef PG8_SA
#undef PG8_SB
#undef PG8_STAGE
#undef PG8_LDA
#undef PG8_LDB
#undef PG8_MMA
#undef PG8_WAIT_V
#undef PG8_WAIT_L
#undef PG8_BAR
#undef PG8_SCHED
}
}
constexpr int NWAVES = 8, NTHR = 512;
constexpr int D = 2048, NB = 2, SEQ = 8192, M = NB * SEQ, CTX = 256, MC = NB * CTX, MA = M + MC;
constexpr int S5W = 1024, SG = 64, SP = 64, SH = 16, HYW = 1024, DFF = 5632, INC = 8192, NADA = 6 * D;
constexpr float EPS = 1e-6f;
constexpr size_t MiB = 1u << 20;
constexpr size_t WS_ADA = 0;
constexpr size_t WS_TR = 1 * MiB;
constexpr size_t WS_TC = WS_TR + 512 * 1024;
constexpr size_t WS_LAMB = 2 * MiB;
constexpr size_t WS_BBAR = WS_LAMB + 64 * 1024;
constexpr size_t WS_LAM16 = 3 * MiB + 256 * 1024, WS_LAM32 = WS_LAM16 + 64 * 1024, WS_LAM1024 = WS_LAM32 + 64 * 1024;
constexpr size_t WS_CTXS = 3 * MiB + 512 * 1024;
constexpr size_t WS_TW = 3 * MiB + 768 * 1024;
constexpr size_t WS_H2 = 4 * MiB;
constexpr size_t WS_RSQ1 = 6 * MiB, WS_RSQ2 = 8 * MiB;
constexpr size_t WS_ADAP = 10 * MiB;
constexpr size_t WS_KD = 12 * MiB + 512 * 1024;
constexpr size_t WS_UCTX = 14 * MiB + 512 * 1024;
constexpr size_t WS_WIN = 16 * MiB, WS_WGLU = 48 * MiB, WS_WHY = 56 * MiB, WS_WOUT = 60 * MiB, WS_WF1 = 68 * MiB, WS_WF2 = 112 * MiB;
constexpr size_t WS_CONVT = 16 * MiB;
constexpr size_t WS_A = 134 * MiB;
constexpr size_t WS_SLOC = WS_A;
constexpr size_t WS_W1T = 200 * MiB, WS_BT2 = 208 * MiB;
constexpr size_t WS_GATES = 224 * MiB;
constexpr size_t WS_HYT = 352 * MiB;
constexpr size_t WS_HYB = 352 * MiB, WS_YG = 384 * MiB;
constexpr size_t WS_MERGED = 416 * MiB;
constexpr size_t WS_A2 = 448 * MiB;
constexpr size_t WS_END = 512 * MiB;
constexpr int LDS_BYTES = 147456;

#define LAS __attribute__((address_space(3)))
typedef unsigned short bf16;
typedef unsigned v4u __attribute__((ext_vector_type(4)));
typedef unsigned v2u __attribute__((ext_vector_type(2)));
typedef float f32x4 __attribute__((ext_vector_type(4)));
#define LDS_WAIT() asm volatile("s_waitcnt lgkmcnt(0)" ::: "memory")
__device__ __forceinline__ unsigned f2bf(float f) { unsigned u = __builtin_bit_cast(unsigned, f); return (u + 0x7fffu + ((u >> 16) & 1u)) >> 16; }
__device__ __forceinline__ unsigned pk2(float lo, float hi) { return f2bf(lo) | (f2bf(hi) << 16); }
__device__ __forceinline__ float bf2f(bf16 v) { return __uint_as_float(((unsigned)v) << 16); }
__device__ __forceinline__ float wave_sum(float v) {
#pragma unroll
    for (int o = 1; o < 64; o <<= 1) v += __shfl_xor(v, o);
    return v;
}
__device__ __forceinline__ float silu_f(float x) { return x / (1.0f + __expf(-x)); }
__device__ __forceinline__ float gelu_tanh(float y) { const float z = 0.7978845608028654f * (y + 0.044715f * y * y * y); const float e = __expf(2.0f * z); return y * (1.0f - 1.0f / (e + 1.0f)); }

struct Args { const float* in[34]; float* out; unsigned char* ws; int ph_lo, ph_hi; };
struct Frame {
    LAS unsigned char* lds; int tid, lane, wave, bid, G;
    const float* in[34]; float* out; unsigned char* ws;
};
enum { I_X = 0, I_C, I_CTX, I_CCTX, I_WADA, I_BADA, I_NMIX, I_WIN, I_ARE, I_AIM, I_LOGDT, I_BRE, I_BIM, I_CRE, I_CIM, I_S5D, I_WGLU, I_CONVW, I_CONVB,
       I_F1W, I_F1B, I_F1F, I_F2W, I_F2B, I_F2F, I_F3W, I_DECAY, I_HBIAS, I_WHY, I_WOUT, I_NFFN, I_WF1, I_WF2, I_NF };

template <bool ILV> __device__ __forceinline__ void transpose_item(const float* W, int K, int N, bf16* WT, LAS float* scr, int item, int lane) {
    const int nblk = N / 32, kb = item / nblk, nb = item % nblk, k0 = 64 * kb, n0 = 32 * nb;
#pragma unroll 8
    for (int i = 0; i < 32; ++i) { const int kk = 2 * i + (lane >> 5); scr[kk * 33 + (lane & 31)] = W[(size_t)(k0 + kk) * N + n0 + (lane & 31)]; }
    LDS_WAIT(); asm volatile("" ::: "memory");
    const int c = lane & 7;
#pragma unroll
    for (int j = 0; j < 4; ++j) { const int n = (lane >> 3) + 8 * j; const LAS float* s = scr + (8 * c) * 33 + n;
        v4u o; o.x = pk2(s[0 * 33], s[1 * 33]); o.y = pk2(s[2 * 33], s[3 * 33]); o.z = pk2(s[4 * 33], s[5 * 33]); o.w = pk2(s[6 * 33], s[7 * 33]);
        int dr = n0 + n;
        if (ILV) { const int half = N >> 1, isg = dr >= half, jj = dr - (isg ? half : 0); dr = 8 * (jj >> 2) + (isg ? 4 : 0) + (jj & 3); }
        *(v4u*)(WT + (size_t)dr * K + k0 + 8 * c) = o; }
    LDS_WAIT(); asm volatile("" ::: "memory");
}
__device__ __forceinline__ void p0_prologue(Frame& F) {
    if (F.bid < 96) {
        LAS float* sc = (LAS float*)F.lds;
        const int ks = F.bid / 6, cb = F.bid % 6, k0 = ks * 128;
        if (F.tid < 384) { const int b = F.tid >> 7, kk = F.tid & 127; const float v = (b < 2) ? F.in[I_C][b * D + k0 + kk] : F.in[I_CCTX][k0 + kk]; sc[F.tid] = silu_f(v); }
        __syncthreads();
        const int col = cb * 2048 + F.tid * 4;
        const float* W = F.in[I_WADA] + (size_t)k0 * NADA + col;
        f32x4 a0 = {0, 0, 0, 0}, a1 = a0, a2 = a0;
#pragma unroll 8
        for (int k = 0; k < 128; ++k) { const f32x4 w = *(const f32x4*)(W + (size_t)k * NADA); a0 += sc[k] * w; a1 += sc[128 + k] * w; a2 += sc[256 + k] * w; }
        float* adap = (float*)(F.ws + WS_ADAP) + (size_t)ks * 3 * NADA;
        *(f32x4*)(adap + col) = a0; *(f32x4*)(adap + NADA + col) = a1; *(f32x4*)(adap + 2 * NADA + col) = a2;
        __syncthreads();
    }
    const int gw = F.bid * NWAVES + F.wave, NGW = F.G * NWAVES, gt = F.bid * NTHR + F.tid, NGT = F.G * NTHR;
    {
        LAS float* scr = (LAS float*)(F.lds + F.wave * 8704);
        constexpr int I1 = (D / 64) * (INC / 32), I2 = (S5W / 64) * (2 * D / 32), I3 = (HYW / 64) * (D / 32), I4 = (D / 64) * (D / 32), I5 = (D / 64) * (2 * DFF / 32), I6 = (DFF / 64) * (D / 32);
        constexpr int NITEMS = I1 + I2 + I3 + I4 + I5 + I6;
        for (int it = gw; it < NITEMS; it += NGW) {
            int r = it;
            if (r < I1) { transpose_item<false>(F.in[I_WIN], D, INC, (bf16*)(F.ws + WS_WIN), scr, r, F.lane); continue; } r -= I1;
            if (r < I2) { transpose_item<true>(F.in[I_WGLU], S5W, 2 * D, (bf16*)(F.ws + WS_WGLU), scr, r, F.lane); continue; } r -= I2;
            if (r < I3) { transpose_item<false>(F.in[I_WHY], HYW, D, (bf16*)(F.ws + WS_WHY), scr, r, F.lane); continue; } r -= I3;
            if (r < I4) { transpose_item<false>(F.in[I_WOUT], D, D, (bf16*)(F.ws + WS_WOUT), scr, r, F.lane); continue; } r -= I4;
            if (r < I5) { transpose_item<true>(F.in[I_WF1], D, 2 * DFF, (bf16*)(F.ws + WS_WF1), scr, r, F.lane); continue; } r -= I5;
            transpose_item<false>(F.in[I_WF2], DFF, D, (bf16*)(F.ws + WS_WF2), scr, r, F.lane);
        }
    }
    {
        float* TR = (float*)(F.ws + WS_TR); float* TC = (float*)(F.ws + WS_TC);
        for (int i = gt; i < 192 * 1024; i += NGT) { const int r = i >> 10, c = i & 1023, k = c & 511;
            const float omega = (float)exp(-(double)k * (9.210340371976184 / 512.0));
            const float ang = (float)(r < 128 ? r : r - 128) * omega;
            const float v = (c < 512) ? (float)sin((double)ang) : (float)cos((double)ang);
            if (r < 128) TR[(size_t)r * 1024 + c] = v; else TC[(size_t)(r - 128) * 1024 + c] = v; }
    }
    { float2* TW = (float2*)(F.ws + WS_TW);
      for (int i = gt; i < 16384; i += NGT) { const double a = -6.283185307179586476925 * (double)i / 16384.0; TW[i] = make_float2((float)cos(a), (float)sin(a)); } }
    {
        float2* LAMB = (float2*)(F.ws + WS_LAMB); float2* BBAR = (float2*)(F.ws + WS_BBAR);
        for (int i = gt; i < 2 * SG * SP; i += NGT) { const int dg = i >> 6;
            const double are = F.in[I_ARE][i], aim = F.in[I_AIM][i], dt = exp((double)F.in[I_LOGDT][dg]);
            const double mag = exp(are * dt), lr = mag * cos(aim * dt), li = mag * sin(aim * dt);
            LAMB[i] = make_float2((float)lr, (float)li);
            { const double m16 = exp(16.0 * are * dt), m32 = exp(32.0 * are * dt), m1k = exp(1024.0 * are * dt);
              ((float2*)(F.ws + WS_LAM16))[i] = make_float2((float)(m16 * cos(16.0 * aim * dt)), (float)(m16 * sin(16.0 * aim * dt)));
              ((float2*)(F.ws + WS_LAM32))[i] = make_float2((float)(m32 * cos(32.0 * aim * dt)), (float)(m32 * sin(32.0 * aim * dt)));
              ((float2*)(F.ws + WS_LAM1024))[i] = make_float2((float)(m1k * cos(1024.0 * aim * dt)), (float)(m1k * sin(1024.0 * aim * dt))); }
            const double den = are * are + aim * aim, qr = ((lr - 1.0) * are + li * aim) / den, qi = (li * are - (lr - 1.0) * aim) / den;
#pragma unroll 4
            for (int h = 0; h < SH; ++h) { const double br = F.in[I_BRE][(size_t)i * SH + h], bi = F.in[I_BIM][(size_t)i * SH + h];
                BBAR[(size_t)i * SH + h] = make_float2((float)(qr * br - qi * bi), (float)(qr * bi + qi * br)); } }
    }
    {
        float* H2 = (float*)(F.ws + WS_H2);
        const int k = F.lane;
        for (int n = gw; n < SEQ; n += NGW) {
            const double t = (double)n / 8191.0, w = 6.283185307179586 * (double)n / 8192.0;
            float feat;
            if (k == 0) feat = (float)t;
            else if (k <= 16) { const double band = 1e-4 + (double)(k - 1) * ((15.0 - 1e-4) / 15.0); feat = (float)cos(w * band); }
            else if (k <= 32) { const double band = 1e-4 + (double)(k - 17) * ((15.0 - 1e-4) / 15.0); feat = (float)(-sin(w * band)); }
            else feat = 0.f;
            float a = F.in[I_F1B][k];
#pragma unroll
            for (int i = 0; i < 33; ++i) a += __shfl(feat, i) * F.in[I_F1W][i * 64 + k];
            const float h1 = sinf(F.in[I_F1F][k] * a);
            float a2 = F.in[I_F2B][k];
#pragma unroll 8
            for (int j = 0; j < 64; ++j) a2 += __shfl(h1, j) * F.in[I_F2W][j * 64 + k];
            H2[(size_t)n * 64 + k] = sinf(F.in[I_F2F][k] * a2);
        }
    }
}
__device__ __forceinline__ void p1_modulate(Frame& F) {
    const int gw = F.bid * NWAVES + F.wave, NGW = F.G * NWAVES;
    const float* TR = (const float*)(F.ws + WS_TR); const float* TC = (const float*)(F.ws + WS_TC);
    bf16* HA = (bf16*)(F.ws + WS_A);
    LAS float* ada = (LAS float*)F.lds;
    const float* adap = (const float*)(F.ws + WS_ADAP);
    for (int e = F.tid; e < 3 * 4096; e += NTHR) { const int b = e >> 12, c = e & 4095; float s = F.in[I_BADA][c];
#pragma unroll
        for (int ks = 0; ks < 16; ++ks) s += adap[(size_t)(ks * 3 + b) * NADA + c];
        ada[e] = s; }
    if (F.tid < 144) { const int e = F.bid * 144 + F.tid, b = e / NADA, c = e % NADA; float s = F.in[I_BADA][c];
#pragma unroll
        for (int ks = 0; ks < 16; ++ks) s += adap[(size_t)(ks * 3 + b) * NADA + c];
        ((float*)(F.ws + WS_ADA))[e] = s; }
    __syncthreads();
    for (int r = gw; r < MA; r += NGW) {
        const bool lat = r < M; const int b = lat ? (r >> 13) : 2, t = r & 8191;
        const float* xr = lat ? (F.in[I_X] + (size_t)r * D) : (F.in[I_CTX] + (size_t)(r - M) * D);
        f32x4 v[8]; float ss = 0.f;
#pragma unroll
        for (int j = 0; j < 8; ++j) { const int c = 4 * F.lane + 256 * j; v[j] = *(const f32x4*)(xr + c);
            if (lat) { const float* pp = (c < 1024) ? (TR + (size_t)(t >> 6) * 1024 + c) : (TC + (size_t)(t & 63) * 1024 + (c - 1024)); v[j] += *(const f32x4*)pp; }
            ss += (v[j][0] * v[j][0] + v[j][1] * v[j][1]) + (v[j][2] * v[j][2] + v[j][3] * v[j][3]); }
        const float rstd = 1.0f / sqrtf(wave_sum(ss) * (1.0f / D) + EPS);
        const LAS float* sh = ada + b * 4096; const LAS float* scl = sh + D;
#pragma unroll
        for (int j = 0; j < 8; ++j) { const int c = 4 * F.lane + 256 * j; const f32x4 g = *(const f32x4*)(F.in[I_NMIX] + c), s1 = *(const LAS f32x4*)(scl + c), s0 = *(const LAS f32x4*)(sh + c);
            const f32x4 o = (v[j] * rstd * g) * (1.0f + s1) + s0;
            v2u w; w.x = pk2(o[0], o[1]); w.y = pk2(o[2], o[3]); *(v2u*)(HA + (size_t)r * D + c) = w; }
    }
}
__device__ __forceinline__ void taps_gen(Frame& F, float* TAPS) {
    const float* H2 = (const float*)(F.ws + WS_H2);
    for (int unit = F.bid; unit < 16 * 32 * 2; unit += F.G) {
        const int nc = unit & 15, cc = (unit >> 4) & 31, d = unit >> 9, n = nc * 512 + F.tid;
        float hrow[64];
#pragma unroll
        for (int k = 0; k < 64; k += 4) { const f32x4 q = *(const f32x4*)(H2 + (size_t)n * 64 + k); hrow[k] = q[0]; hrow[k + 1] = q[1]; hrow[k + 2] = q[2]; hrow[k + 3] = q[3]; }
        const float t = (float)n / 8191.0f;
        for (int ci = 0; ci < 32; ++ci) { const int c = cc * 32 + ci; float a = 0.f;
#pragma unroll
            for (int k = 0; k < 64; ++k) a += hrow[k] * F.in[I_F3W][(size_t)k * 2048 + d * 1024 + c];
            a *= __expf(-t * fabsf(F.in[I_DECAY][d * 1024 + c]));
            if (d == 0) TAPS[(size_t)c * 32768 + n] = a;
            else { if (n >= 1) TAPS[(size_t)c * 32768 + 16384 - n] = a; else TAPS[(size_t)c * 32768 + 8192] = 0.f; } }
    }
}
__device__ __forceinline__ void pn2_modulate(Frame& F) {
    const int gw = F.bid * NWAVES + F.wave, NGW = F.G * NWAVES;
    const float* ada = (const float*)(F.ws + WS_ADA); const float* rsq = (const float*)(F.ws + WS_RSQ1); bf16* HB = (bf16*)(F.ws + WS_A);
    for (int r = gw; r < M; r += NGW) {
        const int b = r >> 13;
        const float ss = wave_sum(F.lane < 32 ? rsq[(size_t)r * 32 + F.lane] : 0.f);
        const float rstd = 1.0f / sqrtf(ss * (1.0f / D) + EPS);
        const float* sh = ada + (size_t)b * NADA + 3 * D; const float* scl = sh + D;
        const float* xr = F.out + (size_t)r * D;
#pragma unroll
        for (int j = 0; j < 8; ++j) { const int c = 4 * F.lane + 256 * j; const f32x4 x = *(const f32x4*)(xr + c), g = *(const f32x4*)(F.in[I_NFFN] + c), s1 = *(const f32x4*)(scl + c), s0 = *(const f32x4*)(sh + c);
            const f32x4 o = (x * rstd * g) * (1.0f + s1) + s0;
            v2u w; w.x = pk2(o[0], o[1]); w.y = pk2(o[2], o[3]); *(v2u*)(HB + (size_t)r * D + c) = w; }
    }
}
__device__ __forceinline__ void pf3_final(Frame& F) {
    const int gw = F.bid * NWAVES + F.wave, NGW = F.G * NWAVES;
    const float* rsq = (const float*)(F.ws + WS_RSQ2);
    for (int r = gw; r < M; r += NGW) {
        const float ss = wave_sum(F.lane < 32 ? rsq[(size_t)r * 32 + F.lane] : 0.f);
        const float rstd = 1.0f / sqrtf(ss * (1.0f / D) + EPS);
        float* xr = F.out + (size_t)r * D;
#pragma unroll
        for (int j = 0; j < 8; ++j) { const int c = 4 * F.lane + 256 * j; const f32x4 x = *(const f32x4*)(xr + c), g = *(const f32x4*)(F.in[I_NF] + c);
            *(f32x4*)(xr + c) = x * rstd * g; }
    }
}
#define FFT_HD __device__ __forceinline__
typedef float cf __attribute__((ext_vector_type(2)));
FFT_HD cf cmulf(cf a, cf b) { cf r; r.x = a.x * b.x - a.y * b.y; r.y = a.x * b.y + a.y * b.x; return r; }
FFT_HD cf cmulcf(cf a, cf b) { cf r; r.x = a.x * b.x + a.y * b.y; r.y = a.y * b.x - a.x * b.y; return r; }
FFT_HD int fft_swz(int e) { return e; }
template <int SGN> FFT_HD void dft4(cf& a, cf& b, cf& c, cf& d) {
    const cf s0 = {a.x + c.x, a.y + c.y}, d0 = {a.x - c.x, a.y - c.y}, s1 = {b.x + d.x, b.y + d.y}, d1 = {b.x - d.x, b.y - d.y};
    const cf id1 = {-d1.y, d1.x};
    a = cf{s0.x + s1.x, s0.y + s1.y}; c = cf{s0.x - s1.x, s0.y - s1.y};
    if (SGN < 0) { b = cf{d0.x - id1.x, d0.y - id1.y}; d = cf{d0.x + id1.x, d0.y + id1.y}; }
    else         { b = cf{d0.x + id1.x, d0.y + id1.y}; d = cf{d0.x - id1.x, d0.y - id1.y}; }
}
template <int SGN> FFT_HD void dft16(cf (&x)[16]) {
    constexpr float C1 = 0.92387953251128674f, S1 = 0.38268343236508977f, R2 = 0.70710678118654752f;
#pragma unroll
    for (int n2 = 0; n2 < 4; ++n2) dft4<SGN>(x[n2], x[4 + n2], x[8 + n2], x[12 + n2]);
    const float sg = (float)SGN;
#define TW(idx, cr, ci) { const cf w = {cr, sg * (ci)}; x[idx] = cmulf(x[idx], w); }
    TW(5, C1, S1) TW(6, R2, R2) TW(7, S1, C1)
    TW(9, R2, R2) { const cf t = x[10]; x[10] = cf{-sg * t.y, sg * t.x}; } TW(11, -R2, R2)
    TW(13, S1, C1) TW(14, -R2, R2) TW(15, -C1, -S1)
#undef TW
#pragma unroll
    for (int k1 = 0; k1 < 4; ++k1) dft4<SGN>(x[4 * k1], x[4 * k1 + 1], x[4 * k1 + 2], x[4 * k1 + 3]);
#pragma unroll
    for (int a = 0; a < 4; ++a)
#pragma unroll
        for (int b = a + 1; b < 4; ++b) { const cf t = x[4 * a + b]; x[4 * a + b] = x[4 * b + a]; x[4 * b + a] = t; }
}
FFT_HD void cpowers16(cf w1, cf (&p)[16]) {
    p[0] = cf{1.f, 0.f}; p[1] = w1; p[2] = cmulf(w1, w1); p[3] = cmulf(p[2], w1); p[4] = cmulf(p[2], p[2]); p[5] = cmulf(p[4], w1); p[6] = cmulf(p[4], p[2]); p[7] = cmulf(p[4], p[3]);
    p[8] = cmulf(p[4], p[4]); p[9] = cmulf(p[8], w1); p[10] = cmulf(p[8], p[2]); p[11] = cmulf(p[8], p[3]); p[12] = cmulf(p[8], p[4]); p[13] = cmulf(p[8], p[5]); p[14] = cmulf(p[8], p[6]); p[15] = cmulf(p[8], p[7]);
}
template <int S, int TWM, class PT> FFT_HD void pass16_fwd(PT d, int q, const cf* W) {
    const int j = q % S, base = (q / S) * (16 * S) + j;
    cf x[16];
#pragma unroll
    for (int m = 0; m < 16; ++m) x[m] = d[fft_swz(base + m * S)];
    dft16<-1>(x);
    cf p[16]; cpowers16(W[j * TWM], p);
#pragma unroll
    for (int k = 1; k < 16; ++k) x[k] = cmulf(x[k], p[k]);
#pragma unroll
    for (int k = 0; k < 16; ++k) d[fft_swz(base + k * S)] = x[k];
}
template <int S, int TWM, class PT> FFT_HD void pass16_inv(PT d, int q, const cf* W) {
    const int j = q % S, base = (q / S) * (16 * S) + j;
    cf x[16];
#pragma unroll
    for (int k = 0; k < 16; ++k) x[k] = d[fft_swz(base + k * S)];
    cf p[16]; cpowers16(W[j * TWM], p);
#pragma unroll
    for (int k = 1; k < 16; ++k) x[k] = cmulcf(x[k], p[k]);
    dft16<1>(x);
#pragma unroll
    for (int m = 0; m < 16; ++m) d[fft_swz(base + m * S)] = x[m];
}
template <class PT> FFT_HD void pass4_fwd_load(PT d, int q, cf (&x)[4]) {
#pragma unroll
    for (int m = 0; m < 4; ++m) x[m] = d[fft_swz(4 * q + m)];
    dft4<-1>(x[0], x[1], x[2], x[3]);
}
template <class PT> FFT_HD void pass4_inv_store(PT d, int q, cf (&x)[4]) {
    dft4<1>(x[0], x[1], x[2], x[3]);
#pragma unroll
    for (int m = 0; m < 4; ++m) d[fft_swz(4 * q + m)] = x[m];
}

typedef LAS cf* ldscf;
__device__ __forceinline__ void fft_fwd3(ldscf d, int tid, const cf* W) {
    pass16_fwd<1024, 1>(d, tid, W); pass16_fwd<1024, 1>(d, tid + 512, W); __syncthreads();
    pass16_fwd<64, 16>(d, tid, W); pass16_fwd<64, 16>(d, tid + 512, W); __syncthreads();
    pass16_fwd<4, 256>(d, tid, W); pass16_fwd<4, 256>(d, tid + 512, W); __syncthreads();
}
__device__ __forceinline__ void fft_inv3(ldscf d, int tid, const cf* W) {
    pass16_inv<4, 256>(d, tid, W); pass16_inv<4, 256>(d, tid + 512, W); __syncthreads();
    pass16_inv<64, 16>(d, tid, W); pass16_inv<64, 16>(d, tid + 512, W); __syncthreads();
    pass16_inv<1024, 1>(d, tid, W); pass16_inv<1024, 1>(d, tid + 512, W); __syncthreads();
}
__device__ __forceinline__ void filter_fft(Frame& F, float* KS) {
    ldscf d = (ldscf)F.lds; const cf* W = (const cf*)(F.ws + WS_TW);
    for (int c = F.bid; c < HYW; c += F.G) {
        __syncthreads();
        const float* tp = KS + (size_t)c * 32768;
        for (int m = F.tid; m < 16384; m += NTHR) d[fft_swz(m)] = cf{tp[m], 0.f};
        __syncthreads();
        fft_fwd3(d, F.tid, W);
        cf* ks = (cf*)tp;
        for (int q = F.tid; q < 4096; q += NTHR) { cf r[4]; pass4_fwd_load(d, q, r);
            f32x4 o0 = {r[0].x, r[0].y, r[1].x, r[1].y}, o1 = {r[2].x, r[2].y, r[3].x, r[3].y};
            *(f32x4*)(ks + 4 * q) = o0 * (1.0f / 16384.0f); *(f32x4*)(ks + 4 * q + 2) = o1 * (1.0f / 16384.0f); }
    }
    __syncthreads();
}
__device__ __forceinline__ float sconv3(const bf16* row, int t, float w0, float w1, float w2, float bb) {
    const float a = t > 0 ? bf2f(row[t - 1]) : 0.f, b = bf2f(row[t]), c = t < SEQ - 1 ? bf2f(row[t + 1]) : 0.f;
    return a * w0 + b * w1 + c * w2 + bb;
}
__device__ __forceinline__ void conv_fft(Frame& F, const float* KS, bf16* CONVT) {
    ldscf d = (ldscf)F.lds; const cf* W = (const cf*)(F.ws + WS_TW);
    const bf16* HYT = (const bf16*)(F.ws + WS_HYT);
    const float* cw = F.in[I_CONVW]; const float* cb = F.in[I_CONVB];
    for (int c = F.bid; c < HYW; c += F.G) {
        __syncthreads();
        const int c1 = 1024 + c, c2 = 2048 + c;
        const float a0 = cw[c1], a1 = cw[3072 + c1], a2 = cw[6144 + c1], ab = cb[c1], v0 = cw[c2], v1 = cw[3072 + c2], v2 = cw[6144 + c2], vb = cb[c2];
        const float x0w0 = cw[c], x0w1 = cw[3072 + c], x0w2 = cw[6144 + c], x0b = cb[c], hb = F.in[I_HBIAS][c];
        const bf16* r1 = HYT + (size_t)c1 * M; const bf16* r2 = HYT + (size_t)c2 * M; const bf16* r0 = HYT + (size_t)c * M;
        for (int t = F.tid; t < SEQ; t += NTHR) {
            const float w0 = sconv3(r1, t, a0, a1, a2, ab) * sconv3(r2, t, v0, v1, v2, vb);
            const float w1 = sconv3(r1 + SEQ, t, a0, a1, a2, ab) * sconv3(r2 + SEQ, t, v0, v1, v2, vb);
            d[fft_swz(t)] = cf{w0, w1}; d[fft_swz(SEQ + t)] = cf{0.f, 0.f}; }
        __syncthreads();
        fft_fwd3(d, F.tid, W);
        const cf* ks = (const cf*)(KS + (size_t)c * 32768);
        for (int q = F.tid; q < 4096; q += NTHR) { cf r[4]; pass4_fwd_load(d, q, r);
            const f32x4 k0 = *(const f32x4*)(ks + 4 * q), k1 = *(const f32x4*)(ks + 4 * q + 2);
            r[0] = cmulf(r[0], cf{k0[0], k0[1]}); r[1] = cmulf(r[1], cf{k0[2], k0[3]}); r[2] = cmulf(r[2], cf{k1[0], k1[1]}); r[3] = cmulf(r[3], cf{k1[2], k1[3]});
            pass4_inv_store(d, q, r); }
        __syncthreads();
        fft_inv3(d, F.tid, W);
        for (int t = F.tid; t < SEQ; t += NTHR) {
            const cf y = d[fft_swz(t)];
            const float w0 = sconv3(r1, t, a0, a1, a2, ab) * sconv3(r2, t, v0, v1, v2, vb);
            const float w1 = sconv3(r1 + SEQ, t, a0, a1, a2, ab) * sconv3(r2 + SEQ, t, v0, v1, v2, vb);
            const float o0 = sconv3(r0, t, x0w0, x0w1, x0w2, x0b) * (y.x + hb * w0), o1 = sconv3(r0 + SEQ, t, x0w0, x0w1, x0w2, x0b) * (y.y + hb * w1);
            CONVT[(size_t)c * M + t] = (bf16)f2bf(o0); CONVT[(size_t)c * M + SEQ + t] = (bf16)f2bf(o1); }
    }
    __syncthreads();
}
__device__ __forceinline__ void transpose_conv(Frame& F, const bf16* CONVT, bf16* HYB) {
    LAS bf16* tl = (LAS bf16*)(F.lds + F.wave * 8704);
    const int gw = F.bid * NWAVES + F.wave, NGW = F.G * NWAVES;
    for (int it = gw; it < 16 * 256; it += NGW) {
        const int cb = it & 15, tb = it >> 4, c0 = cb * 64, t0 = tb * 64;
#pragma unroll
        for (int i = 0; i < 8; ++i) { const int ch = i * 8 + (F.lane >> 3), tk = (F.lane & 7) * 8;
            const v4u v = *(const v4u*)(CONVT + (size_t)(c0 + ch) * M + t0 + tk);
            LAS unsigned* p = (LAS unsigned*)(tl + ch * 66 + tk); p[0] = v.x; p[1] = v.y; p[2] = v.z; p[3] = v.w; }
        LDS_WAIT(); asm volatile("" ::: "memory");
#pragma unroll
        for (int i = 0; i < 8; ++i) { const int tk = i * 8 + (F.lane >> 3), ch = (F.lane & 7) * 8;
            unsigned short e[8];
#pragma unroll
            for (int k = 0; k < 8; ++k) e[k] = tl[(ch + k) * 66 + tk];
            v4u o; o.x = e[0] | ((unsigned)e[1] << 16); o.y = e[2] | ((unsigned)e[3] << 16); o.z = e[4] | ((unsigned)e[5] << 16); o.w = e[6] | ((unsigned)e[7] << 16);
            *(v4u*)(HYB + (size_t)(t0 + tk) * HYW + c0 + ch) = o; }
        LDS_WAIT(); asm volatile("" ::: "memory");
    }
}
__device__ __forceinline__ void s5_kd_gen(Frame& F) {
    const float2* LAMB = (const float2*)(F.ws + WS_LAMB); const float2* BBAR = (const float2*)(F.ws + WS_BBAR); float* KD = (float*)(F.ws + WS_KD);
    for (int task = F.bid * 2 + (F.tid >> 8); task < 128; task += F.G * 2) {
        const int g = task >> 1, d = task & 1, h = (F.tid >> 4) & 15, hp = F.tid & 15, dg = d * 64 + g;
        float acc[16];
#pragma unroll
        for (int k = 0; k < 16; ++k) acc[k] = 0.f;
        for (int p = 0; p < 64; ++p) {
            const float2 lam = LAMB[dg * 64 + p], bb = BBAR[(size_t)(dg * 64 + p) * 16 + hp];
            const float cr = F.in[I_CRE][(size_t)(dg * 16 + h) * 64 + p], ci = F.in[I_CIM][(size_t)(dg * 16 + h) * 64 + p];
            float qr = cr * bb.x - ci * bb.y, qi = cr * bb.y + ci * bb.x;
#pragma unroll
            for (int k = 0; k < 16; ++k) { acc[k] += qr; const float nr = qr * lam.x - qi * lam.y, ni = qr * lam.y + qi * lam.x; qr = nr; qi = ni; }
        }
#pragma unroll
        for (int k = 0; k < 16; ++k) KD[((size_t)(g * 2 + d) * 16 + k) * 256 + h * 16 + hp] = acc[k];
    }
}
__device__ __forceinline__ void s5_w1t_gen(Frame& F) {
    const float2* LAMB = (const float2*)(F.ws + WS_LAMB); const float2* BBAR = (const float2*)(F.ws + WS_BBAR); bf16* W1T = (bf16*)(F.ws + WS_W1T);
    const int gw = F.bid * NWAVES + F.wave, NGW = F.G * NWAVES;
    for (int it = gw; it < 64 * 256; it += NGW) {
        const int g = it >> 8, n = it & 255, d = n >> 7, p = (n & 127) >> 1, ri = n & 1, j = F.lane >> 2, h4 = (F.lane & 3) * 4, dgp = (d * 64 + g) * 64 + p;
        const float2 lam = LAMB[dgp]; const int pw = d ? j : 15 - j;
        float pr = 1.f, pi = 0.f;
        for (int k = 0; k < pw; ++k) { const float nr = pr * lam.x - pi * lam.y, ni = pr * lam.y + pi * lam.x; pr = nr; pi = ni; }
        float o[4];
#pragma unroll
        for (int e = 0; e < 4; ++e) { const float2 bb = BBAR[(size_t)dgp * 16 + h4 + e]; o[e] = ri ? (pr * bb.y + pi * bb.x) : (pr * bb.x - pi * bb.y); }
        v2u w; w.x = pk2(o[0], o[1]); w.y = pk2(o[2], o[3]);
        *(v2u*)(W1T + ((size_t)(g * 256 + n)) * 256 + j * 16 + h4) = w;
    }
}
__device__ __forceinline__ void s5_bt2_gen(Frame& F) {
    const float2* LAMB = (const float2*)(F.ws + WS_LAMB); const float* KD = (const float*)(F.ws + WS_KD); bf16* BT2 = (bf16*)(F.ws + WS_BT2);
    const int gw = F.bid * NWAVES + F.wave, NGW = F.G * NWAVES;
    for (int it = gw; it < 64 * 256; it += NGW) {
        const int g = it >> 8, n = it & 255, i = n >> 4, h = n & 15;
        float o[8];
        const int k0 = F.lane * 8;
        if (k0 < 256) { const int d = k0 >> 7, p0 = (k0 & 127) >> 1, pw = d ? 16 - i : i + 1;
#pragma unroll
            for (int e = 0; e < 4; ++e) { const int p = p0 + e, dg = d * 64 + g; const float2 lam = LAMB[dg * 64 + p];
                float pr = F.in[I_CRE][(size_t)(dg * 16 + h) * 64 + p], pi = F.in[I_CIM][(size_t)(dg * 16 + h) * 64 + p];
                for (int k = 0; k < pw; ++k) { const float nr = pr * lam.x - pi * lam.y, ni = pr * lam.y + pi * lam.x; pr = nr; pi = ni; }
                o[2 * e] = pr; o[2 * e + 1] = -pi; }
        } else { const int kk = k0 - 256, j = kk >> 4, hp0 = kk & 15;
#pragma unroll
            for (int e = 0; e < 8; ++e) { const int hp = hp0 + e; float v;
                if (j < i) v = KD[((size_t)(g * 2 + 0) * 16 + (i - j)) * 256 + h * 16 + hp];
                else if (j > i) v = KD[((size_t)(g * 2 + 1) * 16 + (j - i)) * 256 + h * 16 + hp];
                else v = KD[((size_t)(g * 2 + 0) * 16) * 256 + h * 16 + hp] + KD[((size_t)(g * 2 + 1) * 16) * 256 + h * 16 + hp];
                o[e] = v; } }
        v4u w; w.x = pk2(o[0], o[1]); w.y = pk2(o[2], o[3]); w.z = pk2(o[4], o[5]); w.w = pk2(o[6], o[7]);
        *(v4u*)(BT2 + ((size_t)(g * 256 + n)) * 512 + k0) = w;
    }
}
__device__ __forceinline__ void s5_ctx_states(Frame& F) {
    LAS cf* part = (LAS cf*)F.lds;
    const bf16* UCTX = (const bf16*)(F.ws + WS_UCTX);
    for (int unit = F.bid; unit < 256; unit += F.G) {
        const int b = unit >> 7, d = (unit >> 6) & 1, g = unit & 63, p = F.lane, dgp = (d * 64 + g) * 64 + p;
        const float2 lam = ((const float2*)(F.ws + WS_LAMB))[dgp];
        const float2* BB = (const float2*)(F.ws + WS_BBAR) + (size_t)dgp * 16;
        float2 Bb[16];
#pragma unroll
        for (int h = 0; h < 16; ++h) Bb[h] = BB[h];
        float sr = 0.f, si = 0.f;
        for (int s = 0; s < 32; ++s) { const int step = F.wave * 32 + s, tc = d == 0 ? step : (CTX - 1 - step);
            const bf16* up = UCTX + (size_t)(b * CTX + tc) * 1024 + g * 16;
            const v4u u0 = *(const v4u*)up, u1 = *(const v4u*)(up + 8);
            float uu[16];
            uu[0] = pg8::bf_lo(u0.x); uu[1] = pg8::bf_hi(u0.x); uu[2] = pg8::bf_lo(u0.y); uu[3] = pg8::bf_hi(u0.y); uu[4] = pg8::bf_lo(u0.z); uu[5] = pg8::bf_hi(u0.z); uu[6] = pg8::bf_lo(u0.w); uu[7] = pg8::bf_hi(u0.w);
            uu[8] = pg8::bf_lo(u1.x); uu[9] = pg8::bf_hi(u1.x); uu[10] = pg8::bf_lo(u1.y); uu[11] = pg8::bf_hi(u1.y); uu[12] = pg8::bf_lo(u1.z); uu[13] = pg8::bf_hi(u1.z); uu[14] = pg8::bf_lo(u1.w); uu[15] = pg8::bf_hi(u1.w);
            float br = 0.f, bi = 0.f;
#pragma unroll
            for (int h = 0; h < 16; ++h) { br += Bb[h].x * uu[h]; bi += Bb[h].y * uu[h]; }
            const float nr = lam.x * sr - lam.y * si + br, ni = lam.x * si + lam.y * sr + bi; sr = nr; si = ni; }
        __syncthreads();
        part[F.wave * 64 + p] = cf{sr, si};
        __syncthreads();
        if (F.wave == 0) { const float2 l32 = ((const float2*)(F.ws + WS_LAM32))[dgp]; float ar = 0.f, ai = 0.f;
#pragma unroll
            for (int w = 0; w < 8; ++w) { const cf q = part[w * 64 + p]; const float nr = l32.x * ar - l32.y * ai + q.x, ni = l32.x * ai + l32.y * ar + q.y; ar = nr; ai = ni; }
            ((float2*)(F.ws + WS_CTXS))[(size_t)(b * 2 + d) * 4096 + g * 64 + p] = make_float2(ar, ai); }
    }
    __syncthreads();
}
__device__ __forceinline__ void s5_carry(Frame& F) {
    LAS cf* ex = (LAS cf*)F.lds;
    const float* SL = (const float*)(F.ws + WS_SLOC); bf16* A2 = (bf16*)(F.ws + WS_A2);
    for (int unit = F.bid; unit < 256; unit += F.G) {
        const int b = unit >> 7, d = (unit >> 6) & 1, g = unit & 63, p = F.lane, dgp = (d * 64 + g) * 64 + p;
        const float2 l16 = ((const float2*)(F.ws + WS_LAM16))[dgp], l1024 = ((const float2*)(F.ws + WS_LAM1024))[dgp];
        const size_t rowbase = (size_t)g * 1024 + b * 512;
        float sr = 0.f, si = 0.f;
#pragma unroll 1
        for (int hb = 0; hb < 4; ++hb) {
            float2 v[16];
#pragma unroll
            for (int i = 0; i < 16; ++i) { const int cs = F.wave * 64 + hb * 16 + i, c = d == 0 ? cs : 511 - cs; v[i] = *(const float2*)(SL + (rowbase + c) * 256 + d * 128 + 2 * p); }
#pragma unroll
            for (int i = 0; i < 16; ++i) { const float nr = l16.x * sr - l16.y * si + v[i].x, ni = l16.x * si + l16.y * sr + v[i].y; sr = nr; si = ni; }
        }
        __syncthreads();
        ex[F.wave * 64 + p] = cf{sr, si};
        __syncthreads();
        const float2 init = ((const float2*)(F.ws + WS_CTXS))[(size_t)(b * 2 + d) * 4096 + g * 64 + p];
        float ar = init.x, ai = init.y;
        for (int w = 0; w < F.wave; ++w) { const cf e = ex[w * 64 + p]; const float nr = l1024.x * ar - l1024.y * ai + e.x, ni = l1024.x * ai + l1024.y * ar + e.y; ar = nr; ai = ni; }
#pragma unroll 1
        for (int hb = 0; hb < 4; ++hb) {
            float2 v[16];
#pragma unroll
            for (int i = 0; i < 16; ++i) { const int cs = F.wave * 64 + hb * 16 + i, c = d == 0 ? cs : 511 - cs; v[i] = *(const float2*)(SL + (rowbase + c) * 256 + d * 128 + 2 * p); }
#pragma unroll
            for (int i = 0; i < 16; ++i) { const int cs = F.wave * 64 + hb * 16 + i, c = d == 0 ? cs : 511 - cs;
                *(unsigned*)(A2 + (rowbase + c) * 512 + d * 128 + 2 * p) = pk2(ar, ai);
                const float nr = l16.x * ar - l16.y * ai + v[i].x, ni = l16.x * ai + l16.y * ar + v[i].y; ar = nr; ai = ni; }
        }
    }
    __syncthreads();
}
#ifndef N_PHASES
#define N_PHASES 13
#endif
__global__ void __launch_bounds__(NTHR, 2) mega(Args args) {
    extern __shared__ __attribute__((aligned(16))) unsigned char lds_raw[];
    Frame F;
    F.lds = (LAS unsigned char*)lds_raw;
    F.tid = threadIdx.x; F.lane = F.tid & 63; F.wave = __builtin_amdgcn_readfirstlane(F.tid >> 6);
    F.bid = blockIdx.x; F.G = gridDim.x;
#pragma unroll
    for (int i = 0; i < 34; ++i) F.in[i] = args.in[i];
    F.out = args.out; F.ws = args.ws;
    const int lo = args.ph_lo, hi = args.ph_hi;
    cg::grid_group grid = cg::this_grid();
#define IN(k) (lo <= (k) && (k) < hi)
#define SEAM(k) do { if (IN(k) && IN((k) + 1)) grid.sync(); } while (0)
    unsigned char* ws = F.ws;
    typedef pg8::bf16_t pb;
    if (IN(0)) { p0_prologue(F); } SEAM(0);
    if (IN(1)) { p1_modulate(F); __syncthreads(); taps_gen(F, F.out); s5_kd_gen(F); s5_w1t_gen(F); } SEAM(1);
    if (IN(2)) {
        filter_fft(F, F.out); s5_bt2_gen(F);
        { pg8::Gemm g{(const pb*)(ws + WS_A), (const pb*)(ws + WS_WIN), MA, S5W, D}; pg8::StaticOrder S; S.init(MA, S5W, F.G, F.bid);
          pg8::EpiU E{(pb*)(ws + WS_A2), (pb*)(ws + WS_UCTX)}; pg8::gemm_phase<pg8::EpiU, pg8::StaticOrder, true, true>(F.lds, g, S, E); }
        { pg8::Gemm g{(const pb*)(ws + WS_WIN) + (size_t)S5W * D, (const pb*)(ws + WS_A), 3 * HYW, M, D}; pg8::StaticOrder S; S.init(3 * HYW, M, F.G, F.bid);
          pg8::EpiStoreBf16 E{(pb*)(ws + WS_HYT), M}; pg8::gemm_phase<pg8::EpiStoreBf16, pg8::StaticOrder, true, true>(F.lds, g, S, E); }
        { pg8::Gemm g{(const pb*)(ws + WS_A), (const pb*)(ws + WS_WIN) + (size_t)(S5W + 3 * HYW) * D, M, 2 * D, D}; pg8::StaticOrder S; S.init(M, 2 * D, F.G, F.bid);
          pg8::EpiStoreBf16 E{(pb*)(ws + WS_GATES), 2 * D}; pg8::gemm_phase<pg8::EpiStoreBf16, pg8::StaticOrder, true, true>(F.lds, g, S, E); }
    } SEAM(2);
    if (IN(3)) {
        s5_ctx_states(F);
        { pg8::Gemm g{(const pb*)(ws + WS_A2) + 256, (const pb*)(ws + WS_W1T), 65536, 16384, 256, 512, 256}; pg8::BlockDiagOrder S{F.bid};
          pg8::EpiSloc E{(float*)(ws + WS_SLOC)}; pg8::gemm_phase<pg8::EpiSloc, pg8::BlockDiagOrder, true, true>(F.lds, g, S, E); }
        __syncthreads();
        asm volatile("" : "+v"(F.tid)); F.lane = F.tid & 63;
        conv_fft(F, F.out, (bf16*)(ws + WS_CONVT));
    } SEAM(3);
    if (IN(4)) { s5_carry(F); transpose_conv(F, (const bf16*)(ws + WS_CONVT), (bf16*)(ws + WS_HYB)); } SEAM(4);
    if (IN(5)) {
        { pg8::Gemm g{(const pb*)(ws + WS_A2), (const pb*)(ws + WS_BT2), 65536, 16384, 512, 512, 512}; pg8::BlockDiagOrder S{F.bid};
          pg8::EpiYg E{(pb*)(ws + WS_YG), (const pb*)(ws + WS_A2), F.in[I_S5D]}; pg8::gemm_phase<pg8::EpiYg, pg8::BlockDiagOrder, true, true>(F.lds, g, S, E); }
        { pg8::Gemm g{(const pb*)(ws + WS_HYB), (const pb*)(ws + WS_WHY), M, D, HYW}; pg8::StaticOrder S; S.init(M, D, F.G, F.bid);
          pg8::EpiHyOut E{(pb*)(ws + WS_A), (const pb*)(ws + WS_GATES)}; pg8::gemm_phase<pg8::EpiHyOut, pg8::StaticOrder, true, true>(F.lds, g, S, E); }
    } SEAM(5);
    if (IN(6)) {
        pg8::Gemm g{(const pb*)(ws + WS_YG), (const pb*)(ws + WS_WGLU), M, 2 * D, S5W}; pg8::StaticOrder S; S.init(M, 2 * D, F.G, F.bid);
        pg8::EpiGlu E{(pb*)(ws + WS_MERGED), (const pb*)(ws + WS_GATES), (const pb*)(ws + WS_A)}; pg8::gemm_phase<pg8::EpiGlu, pg8::StaticOrder, true, true>(F.lds, g, S, E);
    } SEAM(6);
    if (IN(7)) {
        pg8::Gemm g{(const pb*)(ws + WS_MERGED), (const pb*)(ws + WS_WOUT), M, D, D}; pg8::StaticOrder S; S.init(M, D, F.G, F.bid);
        pg8::EpiRes E{F.in[I_X], F.out, (const float*)(ws + WS_ADA) + 2 * D, NADA, (const float*)(ws + WS_TR), (const float*)(ws + WS_TC), (float*)(ws + WS_RSQ1)};
        pg8::gemm_phase<pg8::EpiRes, pg8::StaticOrder, true, true>(F.lds, g, S, E);
    } SEAM(7);
    if (IN(8)) { pn2_modulate(F); } SEAM(8);
    if (IN(9)) {
        pg8::Gemm g{(const pb*)(ws + WS_A), (const pb*)(ws + WS_WF1), M, 2 * DFF, D}; pg8::StaticOrder S; S.init(M, 2 * DFF, F.G, F.bid);
        pg8::EpiSwiglu E{(pb*)(ws + WS_GATES)}; pg8::gemm_phase<pg8::EpiSwiglu, pg8::StaticOrder, true, true>(F.lds, g, S, E);
    } SEAM(9);
    if (IN(10)) {
        pg8::Gemm g{(const pb*)(ws + WS_GATES), (const pb*)(ws + WS_WF2), M, D, DFF}; pg8::StaticOrder S; S.init(M, D, F.G, F.bid);
        pg8::EpiRes E{F.out, F.out, (const float*)(ws + WS_ADA) + 5 * D, NADA, nullptr, nullptr, (float*)(ws + WS_RSQ2)};
        pg8::gemm_phase<pg8::EpiRes, pg8::StaticOrder, true, true>(F.lds, g, S, E);
    } SEAM(10);
    if (IN(11)) { pf3_final(F); }
#undef IN
#undef SEAM
}

#ifndef MK_ONE_LAUNCH
#define MK_ONE_LAUNCH 1
#endif
extern "C" void kernel_launch(void* const* d_in, const int* in_sizes, int n_in, void* d_out, int out_size, void* d_ws, size_t ws_size, hipStream_t stream) {
    static int grid = 0;
    if (grid == 0) {
        if (n_in != 34 || out_size != M * D || ws_size < WS_END) { fprintf(stderr, "kernel_launch: unexpected shapes n_in %d out %d ws %zu\n", n_in, out_size, ws_size); grid = -1; return; }
        int dev = 0, cus = 0, per_cu = 0;
        (void)hipGetDevice(&dev); (void)hipDeviceGetAttribute(&cus, hipDeviceAttributeMultiprocessorCount, dev);
        (void)hipFuncSetAttribute((const void*)mega, hipFuncAttributeMaxDynamicSharedMemorySize, LDS_BYTES);
        (void)hipOccupancyMaxActiveBlocksPerMultiprocessor(&per_cu, (const void*)mega, NTHR, LDS_BYTES);
        (void)hipGetLastError();
        grid = cus * (per_cu >= 1 ? 1 : 0);
        if (grid != 256) fprintf(stderr, "kernel_launch: grid %d (cus %d per_cu %d)\n", grid, cus, per_cu);
        if (grid <= 0) { grid = -1; return; }
    }
    if (grid < 0) return;
    Args a{};
    for (int i = 0; i < 34; ++i) a.in[i] = (const float*)d_in[i];
    a.out = (float*)d_out; a.ws = (unsigned char*)d_ws;
#if MK_ONE_LAUNCH
    a.ph_lo = 0; a.ph_hi = 12;
    void* kargs[] = {&a};
    hipError_t e = hipLaunchCooperativeKernel((const void*)mega, dim3(grid), dim3(NTHR), kargs, LDS_BYTES, stream);
    if (e != hipSuccess) fprintf(stderr, "cooperative launch failed: %s (grid %d)\n", hipGetErrorString(e), grid);
#else
    for (int ph = 0; ph < 12; ++ph) { a.ph_lo = ph; a.ph_hi = ph + 1; hipLaunchKernelGGL(mega, dim3(grid), dim3(NTHR), LDS_BYTES, stream, a); }
#endif
}
```

```cpp
#include <hip/hip_runtime.h>
#include <hip/hip_cooperative_groups.h>
#include <cstdio>
#include <cstdint>
namespace cg = cooperative_groups;
namespace pg8 {
#define PG8_LAS __attribute__((address_space(3)))
typedef unsigned short bf16_t;
typedef short bf16x8 __attribute__((ext_vector_type(8)));
typedef float f32x4 __attribute__((ext_vector_type(4)));
typedef unsigned u32x4 __attribute__((ext_vector_type(4)));
constexpr int BM = 256, BK = 64, HALF = 128, HTB = HALF * BK * 2  , STAGE_BYTES = 8 * HTB, NXCD = 8, WGM = 8;

__host__ __device__ __forceinline__ int lds_byte(int r, int c) { const int st = (r >> 4) * 2 + (c >> 5), rr = r & 15, cc = c & 31, ob = rr * 64 + cc * 2; return st * 1024 + (ob ^ (((ob >> 9) & 1) << 5)); }
__host__ __device__ __forceinline__ void stage_rc(int b, int& R, int& C) { const int st = b / 1024, sb = b % 1024, swz = sb ^ (((sb >> 9) & 1) << 5); R = (st >> 1) * 16 + swz / 64; C = (st & 1) * 32 + (swz % 64) / 2; }
__host__ __device__ __forceinline__ int perm32(int rho) { const int n = rho >> 4, i = rho & 15; return 8 * (i >> 2) + 4 * n + (i & 3); }

struct Unit { int pm, pn; };
struct Gemm { const bf16_t* A; const bf16_t* Bt; int M, N, K, lda, ldb; };

struct StaticOrder {
    int nM, nN, nwg, G, c;
    __host__ __device__ void init(int M, int N, int G_, int c_) { nM = M / BM; nN = N / BM; nwg = nM * nN; G = G_; c = c_; }
    __host__ __device__ bool next(int i, Unit& u) const {
        const long L = (long)i * G + c; if (L >= nwg) return false;
        int wgid = (int)L; { const int q = nwg / NXCD, r = nwg % NXCD, xcd = wgid % NXCD, off = wgid / NXCD; wgid = (xcd < r ? xcd * (q + 1) : r * (q + 1) + (xcd - r) * q) + off; }
        const int nig = WGM * nN, gid = wgid / nig, fm = gid * WGM, gsz = (nM - fm) < WGM ? (nM - fm) : WGM;
        u.pm = fm + ((wgid % nig) % gsz); u.pn = (wgid % nig) / gsz; return true;
    }
    __device__ __forceinline__ void a_ready(const Unit&) const {}
    __device__ __forceinline__ void done(const Unit&) const {}
};
__device__ __forceinline__ unsigned cvt_pk_bf16(float lo, float hi) { unsigned r; asm volatile("v_cvt_pk_bf16_f32 %0, %1, %2" : "=v"(r) : "v"(lo), "v"(hi)); return r; }
typedef float f32x2 __attribute__((ext_vector_type(2)));
typedef unsigned u32x2 __attribute__((ext_vector_type(2)));
__device__ __forceinline__ float bf_lo(unsigned w) { return __uint_as_float(w << 16); }
__device__ __forceinline__ float bf_hi(unsigned w) { return __uint_as_float(w & 0xffff0000u); }
__device__ __forceinline__ float sigm(float x) { return __builtin_amdgcn_rcpf(1.0f + __builtin_amdgcn_exp2f(-1.4426950408889634f * x)); }
__device__ __forceinline__ float gelu_t(float y) { const float z = 0.7978845608028654f * (y + 0.044715f * y * y * y); const float e = __builtin_amdgcn_exp2f(2.885390081777927f * z); return y * (1.0f - __builtin_amdgcn_rcpf(e + 1.0f)); }

struct EpiStoreBf16 {
    static constexpr bool PERM = true, AFTER_DRAIN = false;
    bf16_t* O; int ldc;
    __device__ __forceinline__ void operator()(const f32x4 (&acc)[2][2][4][2], const Unit& u, int wr, int wc, int fr, int fq) const {
        const int row0 = u.pm * BM + wr * 64 + fr, col0 = u.pn * BM + wc * 32 + 8 * fq;
#pragma unroll
        for (int ai = 0; ai < 2; ++ai)
#pragma unroll
            for (int m = 0; m < 4; ++m) { bf16_t* rowp = O + (size_t)(row0 + ai * HALF + m * 16) * ldc + col0;
#pragma unroll
                for (int bj = 0; bj < 2; ++bj) { const f32x4 v0 = acc[ai][bj][m][0], v1 = acc[ai][bj][m][1];
                    u32x4 w; w.x = cvt_pk_bf16(v0[0], v0[1]); w.y = cvt_pk_bf16(v0[2], v0[3]); w.z = cvt_pk_bf16(v1[0], v1[1]); w.w = cvt_pk_bf16(v1[2], v1[3]);
                    *(u32x4*)(rowp + bj * HALF) = w; } }
    }
};
struct EpiGateBf16 {
    static constexpr bool PERM = true, AFTER_DRAIN = false;
    bf16_t* O; const float* gate; int ldg;
    __device__ __forceinline__ void operator()(const f32x4 (&acc)[2][2][4][2], const Unit& u, int wr, int wc, int fr, int fq) const {
        const int row0 = u.pm * BM + wr * 64 + fr, col0 = u.pn * BM + wc * 32 + 8 * fq, b = (u.pm * BM) >> 13;
        f32x4 g0[2], g1[2];
#pragma unroll
        for (int bj = 0; bj < 2; ++bj) { g0[bj] = *(const f32x4*)(gate + (size_t)b * ldg + col0 + bj * HALF); g1[bj] = *(const f32x4*)(gate + (size_t)b * ldg + col0 + bj * HALF + 4); }
#pragma unroll
        for (int ai = 0; ai < 2; ++ai)
#pragma unroll
            for (int m = 0; m < 4; ++m) { bf16_t* rowp = O + (size_t)(row0 + ai * HALF + m * 16) * 2048 + col0;
#pragma unroll
                for (int bj = 0; bj < 2; ++bj) { const f32x4 v0 = acc[ai][bj][m][0] * g0[bj], v1 = acc[ai][bj][m][1] * g1[bj];
                    u32x4 w; w.x = cvt_pk_bf16(v0[0], v0[1]); w.y = cvt_pk_bf16(v0[2], v0[3]); w.z = cvt_pk_bf16(v1[0], v1[1]); w.w = cvt_pk_bf16(v1[2], v1[3]);
                    *(u32x4*)(rowp + bj * HALF) = w; } }
    }
};
struct EpiHyOut {
    static constexpr bool PERM = true, AFTER_DRAIN = false;
    bf16_t* O; const bf16_t* gates;
    __device__ __forceinline__ void operator()(const f32x4 (&acc)[2][2][4][2], const Unit& u, int wr, int wc, int fr, int fq) const {
        const int row0 = u.pm * BM + wr * 64 + fr, col0 = u.pn * BM + wc * 32 + 8 * fq;
#pragma unroll
        for (int ai = 0; ai < 2; ++ai) {
            u32x4 gt[4][2];
#pragma unroll
            for (int m = 0; m < 4; ++m)
#pragma unroll
                for (int bj = 0; bj < 2; ++bj) gt[m][bj] = *(const u32x4*)(gates + (size_t)(row0 + ai * HALF + m * 16) * 4096 + 2048 + col0 + bj * HALF);
#pragma unroll
            for (int m = 0; m < 4; ++m) { const size_t row = (size_t)(row0 + ai * HALF + m * 16);
#pragma unroll
                for (int bj = 0; bj < 2; ++bj) { const f32x4 v0 = acc[ai][bj][m][0], v1 = acc[ai][bj][m][1];
                    const u32x4 g = gt[m][bj];
                    u32x4 w; w.x = cvt_pk_bf16(v0[0] * sigm(bf_lo(g.x)), v0[1] * sigm(bf_hi(g.x))); w.y = cvt_pk_bf16(v0[2] * sigm(bf_lo(g.y)), v0[3] * sigm(bf_hi(g.y)));
                    w.z = cvt_pk_bf16(v1[0] * sigm(bf_lo(g.z)), v1[1] * sigm(bf_hi(g.z))); w.w = cvt_pk_bf16(v1[2] * sigm(bf_lo(g.w)), v1[3] * sigm(bf_hi(g.w)));
                    *(u32x4*)(O + row * 2048 + col0 + bj * HALF) = w; } } }
    }
};
struct EpiGlu {
    static constexpr bool PERM = true, AFTER_DRAIN = false;
    bf16_t* O; const bf16_t* gates; const bf16_t* mhy;
    __device__ __forceinline__ void operator()(const f32x4 (&acc)[2][2][4][2], const Unit& u, int wr, int wc, int fr, int fq) const {
        const int row0 = u.pm * BM + wr * 64 + fr, j0 = (u.pn * BM + wc * 32 + 8 * fq) >> 1;
#pragma unroll
        for (int ai = 0; ai < 2; ++ai) {
            u32x2 gs[4][2], mh[4][2];
#pragma unroll
            for (int m = 0; m < 4; ++m)
#pragma unroll
                for (int bj = 0; bj < 2; ++bj) { const size_t row = (size_t)(row0 + ai * HALF + m * 16); const int j = j0 + bj * 64;
                    gs[m][bj] = *(const u32x2*)(gates + row * 4096 + j); mh[m][bj] = *(const u32x2*)(mhy + row * 2048 + j); }
#pragma unroll
            for (int m = 0; m < 4; ++m) { const size_t row = (size_t)(row0 + ai * HALF + m * 16);
#pragma unroll
                for (int bj = 0; bj < 2; ++bj) { const f32x4 v = acc[ai][bj][m][0], g = acc[ai][bj][m][1]; const int j = j0 + bj * 64;
                    const u32x2 gg = gs[m][bj], mm = mh[m][bj];
                    const float o0 = sigm(bf_lo(gg.x)) * v[0] * sigm(g[0]) + bf_lo(mm.x), o1 = sigm(bf_hi(gg.x)) * v[1] * sigm(g[1]) + bf_hi(mm.x);
                    const float o2 = sigm(bf_lo(gg.y)) * v[2] * sigm(g[2]) + bf_lo(mm.y), o3 = sigm(bf_hi(gg.y)) * v[3] * sigm(g[3]) + bf_hi(mm.y);
                    u32x2 w; w.x = cvt_pk_bf16(o0, o1); w.y = cvt_pk_bf16(o2, o3);
                    *(u32x2*)(O + row * 2048 + j) = w; } } }
    }
};
struct EpiSwiglu {
    static constexpr bool PERM = true, AFTER_DRAIN = false;
    bf16_t* O; const float* rsq  ; const float* SW  ;
    __device__ __forceinline__ void operator()(const f32x4 (&acc)[2][2][4][2], const Unit& u, int wr, int wc, int fr, int fq) const {
        const int row0 = u.pm * BM + wr * 64 + fr, c0 = u.pn * BM + wc * 32 + 8 * fq, j0 = c0 >> 1, b = (u.pm * BM) >> 13;
        f32x4 swa[2], swb[2];
#pragma unroll
        for (int bj = 0; bj < 2; ++bj) { swa[bj] = *(const f32x4*)(SW + (size_t)b * 11264 + c0 + bj * HALF); swb[bj] = *(const f32x4*)(SW + (size_t)b * 11264 + c0 + bj * HALF + 4); }
        float rs[2][4];
#pragma unroll
        for (int ai = 0; ai < 2; ++ai)
#pragma unroll
            for (int m = 0; m < 4; ++m) rs[ai][m] = rsq[row0 + ai * HALF + m * 16];
#pragma unroll
        for (int ai = 0; ai < 2; ++ai)
#pragma unroll
            for (int m = 0; m < 4; ++m) { const size_t row = (size_t)(row0 + ai * HALF + m * 16); const float r = __builtin_amdgcn_rsqf(rs[ai][m] * (1.0f / 2048.0f) + 1e-6f);
#pragma unroll
                for (int bj = 0; bj < 2; ++bj) { const f32x4 a = acc[ai][bj][m][0] * r + swa[bj], bb = acc[ai][bj][m][1] * r + swb[bj]; const int j = j0 + bj * 64;
                    u32x2 w; w.x = cvt_pk_bf16(a[0] * sigm(a[0]) * bb[0], a[1] * sigm(a[1]) * bb[1]); w.y = cvt_pk_bf16(a[2] * sigm(a[2]) * bb[2], a[3] * sigm(a[3]) * bb[3]);
                    *(u32x2*)(O + row * 5632 + j) = w; } }
    }
};
struct EpiRes1 {
    static constexpr bool PERM = false, AFTER_DRAIN = false;
    const float* base; float* out; const float* gate; int ldg; const float* TR; const float* TC; float* rsq; bf16_t* XB; const float* gam  ;
    __device__ __forceinline__ void operator()(const f32x4 (&acc)[2][2][4][2], const Unit& u, int wr, int wc, int fr, int fq) const {
        const int row0 = u.pm * BM + wr * 64 + fr, col0 = u.pn * BM + wc * 32 + 4 * fq;
        const int b = (u.pm * BM) >> 13;
        float ss[2][4];
#pragma unroll
        for (int ai = 0; ai < 2; ++ai)
#pragma unroll
            for (int m = 0; m < 4; ++m) ss[ai][m] = 0.f;
        const unsigned e0 = (unsigned)row0 * 2048u + (unsigned)col0;
        const bool left = col0 < 1024; const float* ptab = left ? TR : TC; const unsigned pc = left ? (unsigned)col0 : (unsigned)(col0 - 1024);
#pragma unroll
        for (int bj = 0; bj < 2; ++bj)
#pragma unroll
            for (int n = 0; n < 2; ++n) { const unsigned co = (unsigned)(bj * HALF + n * 16);
                const f32x4 gv = *(const f32x4*)(gate + (size_t)b * ldg + col0 + co), gm = *(const f32x4*)(gam + (size_t)b * 2048 + col0 + co);
                f32x4 bs[2][4];
#pragma unroll
                for (int ai = 0; ai < 2; ++ai)
#pragma unroll
                    for (int m = 0; m < 4; ++m) bs[ai][m] = *(const f32x4*)(base + (e0 + (unsigned)(ai * HALF + m * 16) * 2048u + co));
#pragma unroll
                for (int ai = 0; ai < 2; ++ai)
#pragma unroll
                    for (int m = 0; m < 4; ++m) { const unsigned t = (unsigned)(row0 + ai * HALF + m * 16) & 8191u, eo = e0 + (unsigned)(ai * HALF + m * 16) * 2048u + co;
                        const unsigned po = (left ? (t >> 6) : (t & 63u)) * 1024u + pc + co;
                        const f32x4 o = bs[ai][m] + *(const f32x4*)(ptab + po) + gv * acc[ai][bj][m][n];
                        ss[ai][m] += (o[0] * o[0] + o[1] * o[1]) + (o[2] * o[2] + o[3] * o[3]);
                        *(f32x4*)(out + eo) = o;
                        const f32x4 xg = o * gm; u32x2 w; w.x = cvt_pk_bf16(xg[0], xg[1]); w.y = cvt_pk_bf16(xg[2], xg[3]);
                        *(u32x2*)(XB + eo) = w; }
                asm volatile("" ::: "memory"); }
#pragma unroll
        for (int ai = 0; ai < 2; ++ai)
#pragma unroll
            for (int m = 0; m < 4; ++m) { float v = ss[ai][m]; v += __shfl_xor(v, 16); v += __shfl_xor(v, 32); if (fq == 0) atomicAdd(rsq + row0 + ai * HALF + m * 16, v); }
    }
};
struct EpiRes {
    static constexpr bool PERM = false, AFTER_DRAIN = false;
    const float* base; float* out; const float* gate  ; int ldg; const float* TR; const float* TC; float* rsq;
    __device__ __forceinline__ void operator()(const f32x4 (&acc)[2][2][4][2], const Unit& u, int wr, int wc, int fr, int fq) const {
        const int row0 = u.pm * BM + wr * 64 + fr, col0 = u.pn * BM + wc * 32 + 4 * fq;
        const int b = (u.pm * BM) >> 13;
        f32x4 gv[2][2];
#pragma unroll
        for (int bj = 0; bj < 2; ++bj)
#pragma unroll
            for (int n = 0; n < 2; ++n) gv[bj][n] = *(const f32x4*)(gate + (size_t)b * ldg + col0 + bj * HALF + n * 16);
#pragma unroll
        for (int am = 0; am < 4; ++am) {
            const int ai = am >> 1, m0 = 2 * (am & 1);
            f32x4 bs[2][2][2];
#pragma unroll
            for (int mm = 0; mm < 2; ++mm) { const size_t off = (size_t)(row0 + ai * HALF + (m0 + mm) * 16) * 2048 + col0;
#pragma unroll
                for (int bj = 0; bj < 2; ++bj)
#pragma unroll
                    for (int n = 0; n < 2; ++n) bs[mm][bj][n] = *(const f32x4*)(base + off + bj * HALF + n * 16); }
#pragma unroll
            for (int mm = 0; mm < 2; ++mm) { const int m = m0 + mm; const int row = row0 + ai * HALF + m * 16; const size_t off = (size_t)row * 2048 + col0; float ss = 0.f;
                const float* pp = nullptr;
                if (TR) { const int t = row & 8191; pp = (col0 < 1024) ? (TR + (size_t)(t >> 6) * 1024 + col0) : (TC + (size_t)(t & 63) * 1024 + (col0 - 1024)); }
#pragma unroll
                for (int bj = 0; bj < 2; ++bj)
#pragma unroll
                    for (int n = 0; n < 2; ++n) { f32x4 bv = bs[mm][bj][n];
                        if (TR) bv += *(const f32x4*)(pp + bj * HALF + n * 16);
                        const f32x4 o = bv + gv[bj][n] * acc[ai][bj][m][n];
                        ss += (o[0] * o[0] + o[1] * o[1]) + (o[2] * o[2] + o[3] * o[3]);
                        *(f32x4*)(out + off + bj * HALF + n * 16) = o; }
                ss += __shfl_xor(ss, 16); ss += __shfl_xor(ss, 32);
                if (fq == 0) rsq[(size_t)row * 32 + u.pn * 4 + wc] = ss; } }
    }
};
struct EpiU {
    static constexpr bool PERM = true, AFTER_DRAIN = false;
    bf16_t* A2; bf16_t* UCTX;
    __device__ __forceinline__ void operator()(const f32x4 (&acc)[2][2][4][2], const Unit& u, int wr, int wc, int fr, int fq) const {
        const int row0 = u.pm * BM + wr * 64 + fr, col0 = u.pn * BM + wc * 32 + 8 * fq;
#pragma unroll
        for (int ai = 0; ai < 2; ++ai)
#pragma unroll
            for (int m = 0; m < 4; ++m) { const int row = row0 + ai * HALF + m * 16;
#pragma unroll
                for (int bj = 0; bj < 2; ++bj) { const f32x4 v0 = acc[ai][bj][m][0], v1 = acc[ai][bj][m][1]; const int col = col0 + bj * HALF;
                    u32x4 w; w.x = cvt_pk_bf16(v0[0], v0[1]); w.y = cvt_pk_bf16(v0[2], v0[3]); w.z = cvt_pk_bf16(v1[0], v1[1]); w.w = cvt_pk_bf16(v1[2], v1[3]);
                    if (u.pm < 64) { const int t = row & 8191, b = row >> 13, g = col >> 4, h0 = col & 15;
                        *(u32x4*)(A2 + ((size_t)(g * 1024 + b * 512 + (t >> 4)) * 512 + 256 + (t & 15) * 16 + h0)) = w; }
                    else *(u32x4*)(UCTX + (size_t)(row - 16384) * 1024 + col) = w; } }
    }
};
struct EpiSloc {
    static constexpr bool PERM = false, AFTER_DRAIN = false;
    float* S;
    __device__ __forceinline__ void operator()(const f32x4 (&acc)[2][2][4][2], const Unit& u, int wr, int wc, int fr, int fq) const {
        const int row0 = u.pm * BM + wr * 64 + fr, col0 = wc * 32 + 4 * fq;
#pragma unroll
        for (int ai = 0; ai < 2; ++ai)
#pragma unroll
            for (int m = 0; m < 4; ++m) { float* rowp = S + (size_t)(row0 + ai * HALF + m * 16) * 256 + col0;
#pragma unroll
                for (int bj = 0; bj < 2; ++bj)
#pragma unroll
                    for (int n = 0; n < 2; ++n) *(f32x4*)(rowp + bj * HALF + n * 16) = acc[ai][bj][m][n]; }
    }
};
struct EpiYg {
    static constexpr bool PERM = true, AFTER_DRAIN = false;
    bf16_t* YG; const bf16_t* A2; const float* Dskip;
    __device__ __forceinline__ void operator()(const f32x4 (&acc)[2][2][4][2], const Unit& u, int wr, int wc, int fr, int fq) const {
        const int row0 = u.pm * BM + wr * 64 + fr, col0 = wc * 32 + 8 * fq;
#pragma unroll
        for (int ai = 0; ai < 2; ++ai)
#pragma unroll
            for (int m = 0; m < 4; ++m) { const int R = row0 + ai * HALF + m * 16, g = R >> 10, b = (R >> 9) & 1, c = R & 511;
#pragma unroll
                for (int bj = 0; bj < 2; ++bj) { const f32x4 v0 = acc[ai][bj][m][0], v1 = acc[ai][bj][m][1]; const int col = col0 + bj * HALF, i = col >> 4, h0 = col & 15;
                    const u32x4 uu = *(const u32x4*)(A2 + (size_t)R * 512 + 256 + col);
                    const f32x4 d0 = *(const f32x4*)(Dskip + g * 16 + h0), d1 = *(const f32x4*)(Dskip + g * 16 + h0 + 4);
                    const float y0 = v0[0] + bf_lo(uu.x) * d0[0], y1 = v0[1] + bf_hi(uu.x) * d0[1], y2 = v0[2] + bf_lo(uu.y) * d0[2], y3 = v0[3] + bf_hi(uu.y) * d0[3];
                    const float y4 = v1[0] + bf_lo(uu.z) * d1[0], y5 = v1[1] + bf_hi(uu.z) * d1[1], y6 = v1[2] + bf_lo(uu.w) * d1[2], y7 = v1[3] + bf_hi(uu.w) * d1[3];
                    u32x4 w; w.x = cvt_pk_bf16(gelu_t(y0), gelu_t(y1)); w.y = cvt_pk_bf16(gelu_t(y2), gelu_t(y3)); w.z = cvt_pk_bf16(gelu_t(y4), gelu_t(y5)); w.w = cvt_pk_bf16(gelu_t(y6), gelu_t(y7));
                    *(u32x4*)(YG + (size_t)(b * 8192 + c * 16 + i) * 1024 + g * 16 + h0) = w; } }
    }
};
struct OneUnit {
    int pm, pn; bool has;
    __device__ __forceinline__ bool next(int i, Unit& u) const { if (i != 0 || !has) return false; u.pm = pm; u.pn = pn; return true; }
    __device__ __forceinline__ void a_ready(const Unit&) const {}
    __device__ __forceinline__ void done(const Unit&) const {}
};
struct BlockDiagOrder {
    int c;
    __device__ __forceinline__ bool next(int i, Unit& u) const { if (i != 0 || c >= 256) return false; u.pm = c; u.pn = c >> 2; return true; }
    __device__ __forceinline__ void a_ready(const Unit&) const {}
    __device__ __forceinline__ void done(const Unit&) const {}
};
struct EpiTaps {
    static constexpr bool PERM = true, AFTER_DRAIN = false;
    float* TAPS; const float* decay;
    __device__ __forceinline__ void operator()(const f32x4 (&acc)[2][2][4][2], const Unit& u, int wr, int wc, int fr, int fq) const {
        const int row0 = u.pm * BM + wr * 64 + fr, col0 = u.pn * BM + wc * 32 + 8 * fq;
#pragma unroll
        for (int ai = 0; ai < 2; ++ai)
#pragma unroll
            for (int m = 0; m < 4; ++m) { const int cp = row0 + ai * HALF + m * 16, d = cp >> 10, c = cp & 1023; const float dk = -fabsf(decay[cp]) * (1.4426950408889634f / 8191.0f);
                float* tp = TAPS + (size_t)c * 32768;
#pragma unroll
                for (int bj = 0; bj < 2; ++bj) { const int n0 = col0 + bj * HALF; float v[8];
#pragma unroll
                    for (int e = 0; e < 8; ++e) v[e] = (e < 4 ? acc[ai][bj][m][0][e & 3] : acc[ai][bj][m][1][e & 3]) * __builtin_amdgcn_exp2f(dk * (float)(n0 + e));
                    if (d == 0) { *(f32x4*)(tp + n0) = (f32x4){v[0], v[1], v[2], v[3]}; *(f32x4*)(tp + n0 + 4) = (f32x4){v[4], v[5], v[6], v[7]}; }
                    else {
#pragma unroll
                        for (int e = 0; e < 8; ++e) { if (n0 + e >= 1) tp[16384 - n0 - e] = v[e]; else tp[8192] = 0.f; } } } }
    }
};
template <class Epi, class Sched, bool ALIGN_EPI = false, bool SP2 = false>
__device__ __forceinline__ void gemm_phase(PG8_LAS unsigned char* lds, const Gemm g, const Sched& S, const Epi& E) {
    const int tid = threadIdx.x, wid = __builtin_amdgcn_readfirstlane(tid >> 6), lane = tid & 63, wr = wid >> 2, wc = wid & 3, fr = lane & 15, fq = lane >> 4;
    const int K = g.K, nt = K / BK, lda = g.lda ? g.lda : K, ldb = g.ldb ? g.ldb : K;
    unsigned voffA[2], voffB[2];
#pragma unroll
    for (int i = 0; i < 2; ++i) { int R, C; stage_rc(tid * 16 + i * 8192, R, C); const int Rb = Epi::PERM ? ((R & ~31) + perm32(R & 31)) : R;
        voffA[i] = (unsigned)(R * lda + C) * 2u; voffB[i] = (unsigned)(Rb * ldb + C) * 2u; }
    const size_t kstep = (size_t)(BK * 2);
    const size_t hstepA = (size_t)HALF * lda * 2, hstepB = (size_t)HALF * ldb * 2;
    const size_t tstepA = 2 * hstepA, tstepB = 2 * hstepB;
    const unsigned ldsw = (unsigned)wid * 1024u;
    const int aoff = lds_byte(wr * 64 + fr, fq * 8), boff = lds_byte(wc * 32 + fr, fq * 8);
#define PG8_SA(b, h) (((b) * 2 + (h)) * HTB)
#define PG8_SB(b, h) ((4 + (b) * 2 + (h)) * HTB)
#define PG8_STAGE(bufoff, gbase, voff) do { _Pragma("unroll") for (int _i = 0; _i < 2; ++_i) \
        __builtin_amdgcn_global_load_lds((const unsigned*)((const char*)(gbase) + (voff)[_i]), (PG8_LAS unsigned*)(lds + (bufoff) + ldsw + _i * 8192), 16, 0, 0); } while (0)
#define PG8_LDA(dst, b, h) do { _Pragma("unroll") for (int m = 0; m < 4; ++m) _Pragma("unroll") for (int k = 0; k < 2; ++k) dst[m][k] = *(const PG8_LAS bf16x8*)(lds + PG8_SA(b, h) + aoff + m * 2048 + k * 1024); } while (0)
#define PG8_LDB(dst, b, h) do { _Pragma("unroll") for (int n = 0; n < 2; ++n) _Pragma("unroll") for (int k = 0; k < 2; ++k) dst[n][k] = *(const PG8_LAS bf16x8*)(lds + PG8_SB(b, h) + boff + n * 2048 + k * 1024); } while (0)
#define PG8_MMA(ai, bj, At, Bt) do { __builtin_amdgcn_s_setprio(1); _Pragma("unroll") for (int m = 0; m < 4; ++m) _Pragma("unroll") for (int n = 0; n < 2; ++n) _Pragma("unroll") for (int k = 0; k < 2; ++k) \
        acc[ai][bj][m][n] = __builtin_amdgcn_mfma_f32_16x16x32_bf16(Bt[n][k], At[m][k], acc[ai][bj][m][n], 0, 0, 0); __builtin_amdgcn_s_setprio(0); } while (0)
#define PG8_WAIT_V(n) asm volatile("s_waitcnt vmcnt(" #n ")" ::: "memory")
#define PG8_WAIT_L(n) asm volatile("s_waitcnt lgkmcnt(" #n ")" ::: "memory")
#define PG8_BAR __builtin_amdgcn_s_barrier()
#define PG8_SCHED __builtin_amdgcn_sched_barrier(0)
    Unit cur, nxt; int ui = 0;
    if (!S.next(0, cur)) return;
    f32x4 acc[2][2][4][2];
#pragma unroll
    for (int a = 0; a < 2; ++a)
#pragma unroll
        for (int b = 0; b < 2; ++b)
#pragma unroll
            for (int m = 0; m < 4; ++m)
#pragma unroll
                for (int n = 0; n < 2; ++n) acc[a][b][m][n] = (f32x4){0.f, 0.f, 0.f, 0.f};
    bf16x8 At[4][2], B0[2][2], B1[2][2];
    const char* cA = (const char*)g.A + (size_t)cur.pm * tstepA; const char* cB = (const char*)g.Bt + (size_t)cur.pn * tstepB;
    S.a_ready(cur);
    if constexpr (SP2) {
        PG8_STAGE(PG8_SB(0, 0), cB, voffB); PG8_STAGE(PG8_SB(0, 1), cB + hstepB, voffB); PG8_STAGE(PG8_SA(0, 0), cA, voffA); PG8_STAGE(PG8_SA(0, 1), cA + hstepA, voffA);
        if (wr == 1) PG8_BAR;
        PG8_WAIT_V(2); PG8_BAR;
        PG8_STAGE(PG8_SB(1, 0), cB + kstep, voffB); PG8_STAGE(PG8_SA(1, 0), cA + kstep, voffA); PG8_STAGE(PG8_SB(1, 1), cB + hstepB + kstep, voffB);
        PG8_WAIT_V(6); PG8_BAR;
    } else {
        PG8_STAGE(PG8_SB(0, 0), cB, voffB); PG8_STAGE(PG8_SA(0, 0), cA, voffA); PG8_STAGE(PG8_SB(0, 1), cB + hstepB, voffB); PG8_STAGE(PG8_SA(0, 1), cA + hstepA, voffA);
        if (wr == 1) PG8_BAR;
        PG8_WAIT_V(4); PG8_BAR;
        PG8_STAGE(PG8_SB(1, 0), cB + kstep, voffB); PG8_STAGE(PG8_SA(1, 0), cA + kstep, voffA); PG8_STAGE(PG8_SB(1, 1), cB + hstepB + kstep, voffB);
        PG8_WAIT_V(6); PG8_BAR;
    }
    for (;;) {
        const bool has_next = S.next(ui + 1, nxt);
        const char* nA = has_next ? (const char*)g.A + (size_t)nxt.pm * tstepA : cA; const char* nB = has_next ? (const char*)g.Bt + (size_t)nxt.pn * tstepB : cB;
        for (int t = 0; t < nt; t += 2) {
            const bool last = (t == nt - 2);
            const char* a1 = cA + (size_t)(t + 1) * kstep;
            const char* a2 = last ? nA : cA + (size_t)(t + 2) * kstep; const char* b2 = last ? nB : cB + (size_t)(t + 2) * kstep;
            const char* a3 = a2 + kstep; const char* b3 = b2 + kstep;
            if (last && has_next) S.a_ready(nxt);
            if constexpr (SP2) {
            PG8_LDB(B0, 0, 0); PG8_LDB(B1, 0, 1); PG8_SCHED; PG8_LDA(At, 0, 0); PG8_STAGE(PG8_SA(1, 1), a1 + hstepA, voffA);
            PG8_WAIT_V(8); PG8_WAIT_L(0); PG8_BAR; PG8_MMA(0, 0, At, B0); PG8_MMA(0, 1, At, B1); PG8_BAR; PG8_SCHED;
            PG8_LDA(At, 0, 1); PG8_STAGE(PG8_SB(0, 0), b2, voffB); PG8_STAGE(PG8_SB(0, 1), b2 + hstepB, voffB); PG8_STAGE(PG8_SA(0, 0), a2, voffA);
            PG8_WAIT_V(8); PG8_WAIT_L(0); PG8_BAR; PG8_MMA(1, 0, At, B0); PG8_MMA(1, 1, At, B1); PG8_BAR; PG8_SCHED;
            PG8_LDB(B0, 1, 0); PG8_LDB(B1, 1, 1); PG8_SCHED; PG8_LDA(At, 1, 0); PG8_STAGE(PG8_SA(0, 1), a2 + hstepA, voffA);
            PG8_WAIT_V(8); PG8_WAIT_L(0); PG8_BAR; PG8_MMA(0, 0, At, B0); PG8_MMA(0, 1, At, B1); PG8_BAR; PG8_SCHED;
            PG8_LDA(At, 1, 1); PG8_STAGE(PG8_SB(1, 0), b3, voffB); PG8_STAGE(PG8_SB(1, 1), b3 + hstepB, voffB); PG8_STAGE(PG8_SA(1, 0), a3, voffA);
            PG8_WAIT_V(8); PG8_WAIT_L(0); PG8_BAR; PG8_MMA(1, 0, At, B0); PG8_MMA(1, 1, At, B1); PG8_BAR; PG8_SCHED;
            } else {
            PG8_LDB(B0, 0, 0); PG8_SCHED; PG8_LDA(At, 0, 0); PG8_STAGE(PG8_SA(1, 1), a1 + hstepA, voffA);
            PG8_WAIT_L(8); PG8_BAR; PG8_WAIT_L(0); PG8_MMA(0, 0, At, B0); PG8_BAR; PG8_SCHED;
            PG8_LDB(B1, 0, 1); PG8_STAGE(PG8_SB(0, 0), b2, voffB);
            PG8_BAR; PG8_WAIT_L(0); PG8_MMA(0, 1, At, B1); PG8_BAR;
            PG8_LDA(At, 0, 1); PG8_STAGE(PG8_SA(0, 0), a2, voffA);
            PG8_BAR; PG8_WAIT_L(0); PG8_MMA(1, 0, At, B0); PG8_BAR; PG8_SCHED;
            PG8_STAGE(PG8_SB(0, 1), b2 + hstepB, voffB);
            PG8_WAIT_V(6); PG8_BAR; PG8_MMA(1, 1, At, B1); PG8_BAR;
            PG8_LDB(B0, 1, 0); PG8_SCHED; PG8_LDA(At, 1, 0); PG8_STAGE(PG8_SA(0, 1), a2 + hstepA, voffA);
            PG8_WAIT_L(8); PG8_BAR; PG8_WAIT_L(0); PG8_MMA(0, 0, At, B0); PG8_BAR; PG8_SCHED;
            PG8_LDB(B1, 1, 1); PG8_STAGE(PG8_SB(1, 0), b3, voffB);
            PG8_BAR; PG8_WAIT_L(0); PG8_MMA(0, 1, At, B1); PG8_BAR;
            PG8_LDA(At, 1, 1); PG8_STAGE(PG8_SA(1, 0), a3, voffA);
            PG8_BAR; PG8_WAIT_L(0); PG8_MMA(1, 0, At, B0); PG8_BAR; PG8_SCHED;
            PG8_STAGE(PG8_SB(1, 1), b3 + hstepB, voffB);
            PG8_WAIT_V(6); PG8_BAR; PG8_MMA(1, 1, At, B1); PG8_BAR;
            }
        }
        if constexpr (ALIGN_EPI) { if (wr == 0) PG8_BAR; }
        if constexpr (!Epi::AFTER_DRAIN) { E(acc, cur, wr, wc, fr, fq); S.done(cur); }
        if (!has_next) break;
#pragma unroll
        for (int a = 0; a < 2; ++a)
#pragma unroll
            for (int b = 0; b < 2; ++b)
#pragma unroll
                for (int m = 0; m < 4; ++m)
#pragma unroll
                    for (int n = 0; n < 2; ++n) acc[a][b][m][n] = (f32x4){0.f, 0.f, 0.f, 0.f};
        cur = nxt; cA = nA; cB = nB; ++ui;
        if constexpr (ALIGN_EPI) { if (wr == 1) PG8_BAR; }
    }
    PG8_WAIT_V(0);
    if constexpr (!ALIGN_EPI) { if (wr == 0) PG8_BAR; }
    PG8_BAR;
    if constexpr (Epi::AFTER_DRAIN) { E.fused(acc, cur, wr, wc, fr, fq, lds, wid, lane); S.done(cur); }
#undef PG8_SA
#undef PG8_SB
#undef PG8_STAGE
#undef PG8_LDA
#undef PG8_LDB
#undef PG8_MMA
#undef PG8_WAIT_V
#undef PG8_WAIT_L
#undef PG8_BAR
#undef PG8_SCHED
}
}
constexpr int NWAVES = 8, NTHR = 512;
constexpr int D = 2048, NB = 2, SEQ = 8192, M = NB * SEQ, CTX = 256, MC = NB * CTX, MA = M + MC;
constexpr int S5W = 1024, SG = 64, SP = 64, SH = 16, HYW = 1024, DFF = 5632, INC = 8192, NADA = 6 * D;
constexpr float EPS = 1e-6f;
constexpr size_t MiB = 1u << 20;
constexpr size_t WS_ADA = 0;
constexpr size_t WS_TR = 1 * MiB;
constexpr size_t WS_TC = WS_TR + 512 * 1024;
constexpr size_t WS_LAMB = 2 * MiB;
constexpr size_t WS_BBAR = WS_LAMB + 64 * 1024;
constexpr size_t WS_LAM16 = 3 * MiB + 256 * 1024, WS_LAM32 = WS_LAM16 + 64 * 1024, WS_LAM1024 = WS_LAM32 + 64 * 1024;
constexpr size_t WS_CTXS = 3 * MiB + 512 * 1024;
constexpr size_t WS_TW = 3 * MiB + 768 * 1024;
constexpr size_t WS_H2B = 224 * MiB, WS_F3WT = 228 * MiB;
constexpr size_t WS_RSQ1 = 6 * MiB, WS_RSQ2 = 8 * MiB;
constexpr size_t WS_GAM = 7 * MiB, WS_SW = 7 * MiB + 64 * 1024;
constexpr size_t WS_ADAP = 10 * MiB;
constexpr size_t WS_KD = 12 * MiB + 512 * 1024;
constexpr size_t WS_UCTX = 14 * MiB + 512 * 1024;
constexpr size_t WS_TS = 15 * MiB + 700 * 1024;
constexpr size_t WS_BAR = 15 * MiB + 768 * 1024;
constexpr size_t WS_WIN = 16 * MiB, WS_WGLU = 48 * MiB, WS_WHY = 56 * MiB, WS_WOUT = 60 * MiB, WS_WF1 = 68 * MiB, WS_WF2 = 112 * MiB;
constexpr size_t WS_CONVT = 16 * MiB;
constexpr size_t WS_A = 134 * MiB;
constexpr size_t WS_SLOC = WS_A;
constexpr size_t WS_W1T = 200 * MiB, WS_BT2 = 208 * MiB;
constexpr size_t WS_GATES = 224 * MiB;
constexpr size_t WS_HYT = 352 * MiB;
constexpr size_t WS_HYB = 352 * MiB, WS_YG = 384 * MiB;
constexpr size_t WS_MERGED = 416 * MiB;
constexpr size_t WS_A2 = 448 * MiB;
constexpr size_t WS_END = 512 * MiB;
constexpr int LDS_BYTES = 147456;

#define LAS __attribute__((address_space(3)))
typedef unsigned short bf16;
typedef unsigned v4u __attribute__((ext_vector_type(4)));
typedef unsigned v2u __attribute__((ext_vector_type(2)));
typedef float f32x4 __attribute__((ext_vector_type(4)));
#define LDS_WAIT() asm volatile("s_waitcnt lgkmcnt(0)" ::: "memory")
__device__ __forceinline__ unsigned f2bf(float f) { unsigned u = __builtin_bit_cast(unsigned, f); return (u + 0x7fffu + ((u >> 16) & 1u)) >> 16; }
__device__ __forceinline__ unsigned pk2(float lo, float hi) { return f2bf(lo) | (f2bf(hi) << 16); }
__device__ __forceinline__ float bf2f(bf16 v) { return __uint_as_float(((unsigned)v) << 16); }
__device__ __forceinline__ float wave_sum(float v) {
#pragma unroll
    for (int o = 1; o < 64; o <<= 1) v += __shfl_xor(v, o);
    return v;
}
__device__ __forceinline__ float silu_f(float x) { return x / (1.0f + __expf(-x)); }
__device__ __forceinline__ float gelu_tanh(float y) { const float z = 0.7978845608028654f * (y + 0.044715f * y * y * y); const float e = __expf(2.0f * z); return y * (1.0f - 1.0f / (e + 1.0f)); }

typedef __attribute__((address_space(1))) unsigned gu32;
#define XB_TMO      128
#define XB_XCNT(j)  (256  + 64 * (j))
#define XB_XSUB(j)  (1280 + 64 * (j))
#define XB_XGEN(j)  (2304 + 64 * (j))
#define XB_TOP      3328
#define XB_TOPGEN   3392
#define XCD_BAR_WORDS 3456
#define XB_SPIN_CAP (1u << 18)

__device__ __forceinline__ unsigned xb_ld(unsigned* p)              { return __hip_atomic_load(p, __ATOMIC_RELAXED, __HIP_MEMORY_SCOPE_AGENT); }
__device__ __forceinline__ unsigned xb_add(unsigned* p, unsigned v) { return __hip_atomic_fetch_add(p, v, __ATOMIC_RELAXED, __HIP_MEMORY_SCOPE_AGENT); }
__device__ __forceinline__ unsigned xb_xcc_id() { return (unsigned)__builtin_amdgcn_s_getreg((3 << 11) | 20) & 0xFu; }
#define XB_SPIN(cond, bar) do { unsigned _sp = 0; while (cond) { __builtin_amdgcn_s_sleep(1); \
    if ((++_sp & 255u) == 0u) { if (xb_ld(&(bar)[XB_TMO])) break; if (_sp > XB_SPIN_CAP) { atomicAdd(&(bar)[XB_TMO], 1u); break; } } } } while (0)

struct XcdBarrier {
    unsigned* bar; unsigned x;
    volatile LAS unsigned* st;
};

__device__ __forceinline__ XcdBarrier xcd_barrier_post(unsigned* bar, volatile LAS unsigned* st) {
    XcdBarrier b; b.bar = bar; b.x = xb_xcc_id(); b.st = st;
    if (threadIdx.x == 0) (void)xb_add(&bar[XB_XCNT(b.x)], 1u);
    return b;
}
__device__ __forceinline__ void xcd_barrier_complete(unsigned* bar, unsigned x, unsigned& nloc, unsigned& nx) {
    const unsigned G = gridDim.x * gridDim.y * gridDim.z;
    unsigned sum, cnt, mine, sp = 0u;
    for (;;) {
        sum = 0u; cnt = 0u; mine = 0u;
#pragma unroll
        for (unsigned j = 0; j < 16; ++j) { const unsigned c = xb_ld(&bar[XB_XCNT(j)]); sum += c; cnt += (c > 0u) ? 1u : 0u; mine = (j == x) ? c : mine; }
        if (sum == G) break;
        __builtin_amdgcn_s_sleep(1);
        if ((++sp & 255u) == 0u) { if (xb_ld(&bar[XB_TMO])) break; if (sp > XB_SPIN_CAP) { atomicAdd(&bar[XB_TMO], 1u); break; } }
    }
    nloc = mine > 0u ? mine : 1u; nx = cnt > 0u ? cnt : 1u;
}

__device__ __forceinline__ void xcd_barrier(const XcdBarrier& b) {
    asm volatile("s_waitcnt vmcnt(0)" ::: "memory");
    __syncthreads();
    if (threadIdx.x == 0) {
        unsigned* bar = b.bar;
        __builtin_amdgcn_s_waitcnt(0);
        unsigned nloc = b.st[0], nx = b.st[1];
        if (nloc == 0u) { xcd_barrier_complete(bar, b.x, nloc, nx); b.st[0] = nloc; b.st[1] = nx; }
        const unsigned old = xb_add(&bar[XB_XSUB(b.x)], 1u);
        const unsigned gen = old / nloc;
        if (old + 1u == (gen + 1u) * nloc) {
            __builtin_amdgcn_fence(__ATOMIC_RELEASE, "agent");
            asm volatile("s_waitcnt vmcnt(0)" ::: "memory");
            const unsigned og = xb_add(&bar[XB_TOP], 1u);
            const unsigned tg = og / nx;
            if (og + 1u == (tg + 1u) * nx) xb_add(&bar[XB_TOPGEN], 1u);
            else XB_SPIN(xb_ld(&bar[XB_TOPGEN]) == tg, bar);
            __builtin_amdgcn_fence(__ATOMIC_ACQUIRE, "agent");
            xb_add(&bar[XB_XGEN(b.x)], 1u);
            asm volatile("s_waitcnt vmcnt(0)" ::: "memory");
        } else {
            XB_SPIN(xb_ld(&bar[XB_XGEN(b.x)]) == gen, bar);
            __builtin_amdgcn_fence(__ATOMIC_ACQUIRE, "agent");
            asm volatile("s_waitcnt vmcnt(0)" ::: "memory");
        }
    }
    __syncthreads();
}

struct Args { const float* in[34]; float* out; unsigned char* ws; int ph_lo, ph_hi; };
struct Frame {
    LAS unsigned char* lds; int tid, lane, wave, bid, G;
    const float* in[34]; float* out; unsigned char* ws;
};
enum { I_X = 0, I_C, I_CTX, I_CCTX, I_WADA, I_BADA, I_NMIX, I_WIN, I_ARE, I_AIM, I_LOGDT, I_BRE, I_BIM, I_CRE, I_CIM, I_S5D, I_WGLU, I_CONVW, I_CONVB,
       I_F1W, I_F1B, I_F1F, I_F2W, I_F2B, I_F2F, I_F3W, I_DECAY, I_HBIAS, I_WHY, I_WOUT, I_NFFN, I_WF1, I_WF2, I_NF };

template <bool ILV> __device__ __forceinline__ void transpose_item(const float* W, int K, int N, bf16* WT, LAS float* scr, int item, int lane) {
    const int nblk = N / 32, kb = item / nblk, nb = item % nblk, k0 = 64 * kb, n0 = 32 * nb;
    float tmp[32];
#pragma unroll
    for (int i = 0; i < 32; ++i) { const int kk = 2 * i + (lane >> 5); tmp[i] = W[(size_t)(k0 + kk) * N + n0 + (lane & 31)]; }
#pragma unroll
    for (int i = 0; i < 32; ++i) { const int kk = 2 * i + (lane >> 5); scr[kk * 33 + (lane & 31)] = tmp[i]; }
    LDS_WAIT(); asm volatile("" ::: "memory");
    const int c = lane & 7;
#pragma unroll
    for (int j = 0; j < 4; ++j) { const int n = (lane >> 3) + 8 * j; const LAS float* s = scr + (8 * c) * 33 + n;
        v4u o; o.x = pk2(s[0 * 33], s[1 * 33]); o.y = pk2(s[2 * 33], s[3 * 33]); o.z = pk2(s[4 * 33], s[5 * 33]); o.w = pk2(s[6 * 33], s[7 * 33]);
        int dr = n0 + n;
        if (ILV) { const int half = N >> 1, isg = dr >= half, jj = dr - (isg ? half : 0); dr = 8 * (jj >> 2) + (isg ? 4 : 0) + (jj & 3); }
        *(v4u*)(WT + (size_t)dr * K + k0 + 8 * c) = o; }
    LDS_WAIT(); asm volatile("" ::: "memory");
}
constexpr int WC_I1 = (D / 64) * (INC / 32), WC_I2 = (S5W / 64) * (2 * D / 32), WC_I3 = (HYW / 64) * (D / 32), WC_I4 = (D / 64) * (D / 32), WC_I5 = (D / 64) * (2 * DFF / 32), WC_I6 = (DFF / 64) * (D / 32);
constexpr int WCONV_ITEMS = WC_I1 + WC_I2 + WC_I3 + WC_I4 + WC_I5 + WC_I6;
__device__ __forceinline__ void wconv_item(Frame& F, LAS float* scr, int it) {
    int r = it;
    if (r < WC_I1) { transpose_item<false>(F.in[I_WIN], D, INC, (bf16*)(F.ws + WS_WIN), scr, r, F.lane); return; } r -= WC_I1;
    if (r < WC_I2) { transpose_item<true>(F.in[I_WGLU], S5W, 2 * D, (bf16*)(F.ws + WS_WGLU), scr, r, F.lane); return; } r -= WC_I2;
    if (r < WC_I3) { transpose_item<false>(F.in[I_WHY], HYW, D, (bf16*)(F.ws + WS_WHY), scr, r, F.lane); return; } r -= WC_I3;
    if (r < WC_I4) { transpose_item<false>(F.in[I_WOUT], D, D, (bf16*)(F.ws + WS_WOUT), scr, r, F.lane); return; } r -= WC_I4;
    if (r < WC_I5) { transpose_item<true>(F.in[I_WF1], D, 2 * DFF, (bf16*)(F.ws + WS_WF1), scr, r, F.lane); return; } r -= WC_I5;
    transpose_item<false>(F.in[I_WF2], DFF, D, (bf16*)(F.ws + WS_WF2), scr, r, F.lane);
}
#ifndef PROBE_DUP
#define PROBE_DUP 0
#endif
#define REPF(bit) for (int rep_ = 0; rep_ < 1 + ((PROBE_DUP >> (bit)) & 1); ++rep_)
__device__ __forceinline__ void p0_prologue(Frame& F) {
    if (F.bid == 0) { unsigned* bw = (unsigned*)(F.ws + WS_BAR); for (int i = F.tid; i < XCD_BAR_WORDS; i += NTHR) bw[i] = 0u; }
    if (F.bid < 96) {
        LAS float* sc = (LAS float*)F.lds;
        const int ks = F.bid / 6, cb = F.bid % 6, k0 = ks * 128;
        if (F.tid < 384) { const int b = F.tid >> 7, kk = F.tid & 127; const float v = (b < 2) ? F.in[I_C][b * D + k0 + kk] : F.in[I_CCTX][k0 + kk]; sc[F.tid] = silu_f(v); }
        __syncthreads();
        const int col = cb * 2048 + F.tid * 4;
        const float* W = F.in[I_WADA] + (size_t)k0 * NADA + col;
        f32x4 a0 = {0, 0, 0, 0}, a1 = a0, a2 = a0;
#pragma unroll 8
        for (int k = 0; k < 128; ++k) { const f32x4 w = *(const f32x4*)(W + (size_t)k * NADA); a0 += sc[k] * w; a1 += sc[128 + k] * w; a2 += sc[256 + k] * w; }
        float* adap = (float*)(F.ws + WS_ADAP) + (size_t)ks * 3 * NADA;
        *(f32x4*)(adap + col) = a0; *(f32x4*)(adap + NADA + col) = a1; *(f32x4*)(adap + 2 * NADA + col) = a2;
        __syncthreads();
    }
    const int gw = F.bid * NWAVES + F.wave, NGW = F.G * NWAVES, gt = F.bid * NTHR + F.tid, NGT = F.G * NTHR;
    {
        LAS float* scr = (LAS float*)(F.lds + F.wave * 8704);
        constexpr int NA = 160 * NWAVES * 7;
        if (F.bid >= 96) for (int it = (F.bid - 96) * NWAVES + F.wave; it < NA; it += 160 * NWAVES) wconv_item(F, scr, it);
        for (int it = NA + gw; it < WCONV_ITEMS; it += NGW) wconv_item(F, scr, it);
    }
    {
        float* TR = (float*)(F.ws + WS_TR); float* TC = (float*)(F.ws + WS_TC);
        for (int i = gt; i < 192 * 1024; i += NGT) { const int r = i >> 10, c = i & 1023, k = c & 511;
            const float omega = (float)exp(-(double)k * (9.210340371976184 / 512.0));
            const float ang = (float)(r < 128 ? r : r - 128) * omega;
            const float v = (c < 512) ? (float)sin((double)ang) : (float)cos((double)ang);
            if (r < 128) TR[(size_t)r * 1024 + c] = v; else TC[(size_t)(r - 128) * 1024 + c] = v; }
    }
    { bf16* F3 = (bf16*)(F.ws + WS_F3WT);
      for (int i = gt; i < 2048 * 64; i += NGT) { const int k = i >> 11, c = i & 2047; const float w = F.in[I_F3W][i]; const unsigned hi = f2bf(w), lo = f2bf(w - __uint_as_float(hi << 16));
          bf16* fr = F3 + (size_t)c * 256; fr[k] = (bf16)hi; fr[64 + k] = (bf16)lo; fr[128 + k] = (bf16)hi; fr[192 + k] = 0; } }
    { float* rz = (float*)(F.ws + WS_RSQ1); for (int i = gt; i < M; i += NGT) rz[i] = 0.f; }
    { float2* TW = (float2*)(F.ws + WS_TW);
      for (int i = gt; i < 16384; i += NGT) { const double a = -6.283185307179586476925 * (double)i / 16384.0; TW[i] = make_float2((float)cos(a), (float)sin(a)); } }
    {
        float2* LAMB = (float2*)(F.ws + WS_LAMB); float2* BBAR = (float2*)(F.ws + WS_BBAR);
        for (int i = gt; i < 2 * SG * SP; i += NGT) { const int dg = i >> 6;
            const double are = F.in[I_ARE][i], aim = F.in[I_AIM][i], dt = exp((double)F.in[I_LOGDT][dg]);
            const double mag = exp(are * dt), lr = mag * cos(aim * dt), li = mag * sin(aim * dt);
            LAMB[i] = make_float2((float)lr, (float)li);
            { const double m16 = exp(16.0 * are * dt), m32 = exp(32.0 * are * dt), m1k = exp(1024.0 * are * dt);
              ((float2*)(F.ws + WS_LAM16))[i] = make_float2((float)(m16 * cos(16.0 * aim * dt)), (float)(m16 * sin(16.0 * aim * dt)));
              ((float2*)(F.ws + WS_LAM32))[i] = make_float2((float)(m32 * cos(32.0 * aim * dt)), (float)(m32 * sin(32.0 * aim * dt)));
              ((float2*)(F.ws + WS_LAM1024))[i] = make_float2((float)(m1k * cos(1024.0 * aim * dt)), (float)(m1k * sin(1024.0 * aim * dt))); }
            const double den = are * are + aim * aim, qr = ((lr - 1.0) * are + li * aim) / den, qi = (li * are - (lr - 1.0) * aim) / den;
#pragma unroll 4
            for (int h = 0; h < SH; ++h) { const double br = F.in[I_BRE][(size_t)i * SH + h], bi = F.in[I_BIM][(size_t)i * SH + h];
                BBAR[(size_t)i * SH + h] = make_float2((float)(qr * br - qi * bi), (float)(qr * bi + qi * br)); } }
    }
    {
        bf16* H2B = (bf16*)(F.ws + WS_H2B);
        const int k = F.lane;
        for (int n = gw; n < SEQ; n += NGW) {
            const double t = (double)n / 8191.0, w = 6.283185307179586 * (double)n / 8192.0;
            float feat;
            if (k == 0) feat = (float)t;
            else if (k <= 16) { const double band = 1e-4 + (double)(k - 1) * ((15.0 - 1e-4) / 15.0); feat = (float)cos(w * band); }
            else if (k <= 32) { const double band = 1e-4 + (double)(k - 17) * ((15.0 - 1e-4) / 15.0); feat = (float)(-sin(w * band)); }
            else feat = 0.f;
            float a = F.in[I_F1B][k];
#pragma unroll
            for (int i = 0; i < 33; ++i) a += __shfl(feat, i) * F.in[I_F1W][i * 64 + k];
            const float h1 = sinf(F.in[I_F1F][k] * a);
            float a2 = F.in[I_F2B][k];
#pragma unroll 8
            for (int j = 0; j < 64; ++j) a2 += __shfl(h1, j) * F.in[I_F2W][j * 64 + k];
            { const float hv = sinf(F.in[I_F2F][k] * a2); const unsigned hi = f2bf(hv), lo = f2bf(hv - __uint_as_float(hi << 16));
              bf16* hr = H2B + (size_t)n * 256; hr[k] = (bf16)hi; hr[64 + k] = (bf16)hi; hr[128 + k] = (bf16)lo; hr[192 + k] = 0; }
        }
    }
}
__device__ __forceinline__ void ada_reduce(Frame& F) {
    if (F.tid < 144) { const float* adap = (const float*)(F.ws + WS_ADAP); const int e = F.bid * 144 + F.tid, b = e / NADA, c = e % NADA; float s = F.in[I_BADA][c];
#pragma unroll
        for (int ks = 0; ks < 16; ++ks) s += adap[(size_t)(ks * 3 + b) * NADA + c];
        ((float*)(F.ws + WS_ADA))[e] = s; }
}
__device__ __forceinline__ void ffn_fold_tables(Frame& F) {
    const float* ada = (const float*)(F.ws + WS_ADA); float* GAM = (float*)(F.ws + WS_GAM); float* SW = (float*)(F.ws + WS_SW);
    const int gw = F.bid * NWAVES + F.wave, NGW = F.G * NWAVES, gt = F.bid * NTHR + F.tid, NGT = F.G * NTHR;
    for (int i = gt; i < 2 * D; i += NGT) { const int b = i >> 11, c = i & 2047; GAM[i] = F.in[I_NFFN][c] * (1.0f + ada[(size_t)b * NADA + 4 * D + c]); }
    const bf16* WT = (const bf16*)(F.ws + WS_WF1);
    for (int n = gw; n < 2 * DFF; n += NGW) {
        float s0 = 0.f, s1 = 0.f;
#pragma unroll
        for (int q = 0; q < 4; ++q) { const int k = q * 512 + F.lane * 8; const v4u w = *(const v4u*)(WT + (size_t)n * D + k);
            const float wf[8] = {pg8::bf_lo(w.x), pg8::bf_hi(w.x), pg8::bf_lo(w.y), pg8::bf_hi(w.y), pg8::bf_lo(w.z), pg8::bf_hi(w.z), pg8::bf_lo(w.w), pg8::bf_hi(w.w)};
            const f32x4 a0 = *(const f32x4*)(ada + 3 * D + k), a1 = *(const f32x4*)(ada + 3 * D + k + 4), b0 = *(const f32x4*)(ada + NADA + 3 * D + k), b1 = *(const f32x4*)(ada + NADA + 3 * D + k + 4);
#pragma unroll
            for (int e = 0; e < 4; ++e) { s0 += wf[e] * a0[e] + wf[4 + e] * a1[e]; s1 += wf[e] * b0[e] + wf[4 + e] * b1[e]; } }
        s0 = wave_sum(s0); s1 = wave_sum(s1);
        if (F.lane == 0) { SW[n] = s0; SW[2 * DFF + n] = s1; }
    }
}
__device__ __forceinline__ void mod_group8(Frame& F, int r0  , const float* TR, const float* TC, const float* ada, bf16* HA) {
    const bool lat = r0 < M; const int b = lat ? (r0 >> 13) : 2;
    const float* sh = ada + (size_t)b * NADA; const float* scl = sh + D;
    f32x4 gs[8], sv[8], pr[4];
#pragma unroll
    for (int j = 0; j < 8; ++j) { const int c = 4 * F.lane + 256 * j; gs[j] = *(const f32x4*)(F.in[I_NMIX] + c) * (1.0f + *(const f32x4*)(scl + c)); sv[j] = *(const f32x4*)(sh + c); }
#pragma unroll
    for (int j = 0; j < 4; ++j) pr[j] = lat ? *(const f32x4*)(TR + (size_t)((r0 & 8191) >> 6) * 1024 + 4 * F.lane + 256 * j) : (f32x4){0.f, 0.f, 0.f, 0.f};
#pragma unroll 1
    for (int i = 0; i < 8; i += 2) {
        f32x4 v[2][8];
#pragma unroll
        for (int q = 0; q < 2; ++q) { const int r = r0 + i + q;
            const float* xr = lat ? (F.in[I_X] + (size_t)r * D) : (F.in[I_CTX] + (size_t)(r - M) * D);
#pragma unroll
            for (int j = 0; j < 8; ++j) v[q][j] = *(const f32x4*)(xr + 4 * F.lane + 256 * j);
            if (lat) {
#pragma unroll
                for (int j = 4; j < 8; ++j) v[q][j] += *(const f32x4*)(TC + (size_t)(r & 63) * 1024 + 4 * F.lane + 256 * (j - 4)); } }
#pragma unroll
        for (int q = 0; q < 2; ++q) { const int r = r0 + i + q; float ss = 0.f;
#pragma unroll
            for (int j = 0; j < 4; ++j) v[q][j] += pr[j];
#pragma unroll
            for (int j = 0; j < 8; ++j) ss += (v[q][j][0] * v[q][j][0] + v[q][j][1] * v[q][j][1]) + (v[q][j][2] * v[q][j][2] + v[q][j][3] * v[q][j][3]);
            const float rstd = 1.0f / sqrtf(wave_sum(ss) * (1.0f / D) + EPS);
#pragma unroll
            for (int j = 0; j < 8; ++j) { const f32x4 o = (v[q][j] * rstd) * gs[j] + sv[j];
                v2u w; w.x = pk2(o[0], o[1]); w.y = pk2(o[2], o[3]); *(v2u*)(HA + (size_t)r * D + 4 * F.lane + 256 * j) = w; } }
    }
}
__device__ __forceinline__ void p1_modulate(Frame& F) {
    const int gw = F.bid * NWAVES + F.wave, NGW = F.G * NWAVES;
    for (int grp = gw; grp < MA / 8; grp += NGW) mod_group8(F, grp * 8, (const float*)(F.ws + WS_TR), (const float*)(F.ws + WS_TC), (const float*)(F.ws + WS_ADA), (bf16*)(F.ws + WS_A));
}
typedef short bf16x8v __attribute__((ext_vector_type(8)));
typedef float f32x16 __attribute__((ext_vector_type(16)));
__device__ __forceinline__ void ctx_gemm_small(Frame& F) {
    if (F.bid >= 256) return;
    const bf16* HA = (const bf16*)(F.ws + WS_A) + (size_t)M * D; const bf16* WT = (const bf16*)(F.ws + WS_WIN); bf16* UCTX = (bf16*)(F.ws + WS_UCTX);
    LAS float* red = (LAS float*)F.lds;
    const int tr = F.bid >> 4, tc = F.bid & 15, r = F.lane & 31, h = F.lane >> 5, k0 = F.wave * 256 + 8 * h;
    const bf16* ap = HA + (size_t)(tr * 32 + r) * D + k0; const bf16* b0p = WT + (size_t)(tc * 64 + r) * D + k0; const bf16* b1p = b0p + (size_t)32 * D;
    f32x16 c0, c1;
#pragma unroll
    for (int i = 0; i < 16; ++i) { c0[i] = 0.f; c1[i] = 0.f; }
#pragma unroll 1
    for (int hh = 0; hh < 2; ++hh) {
        bf16x8v a[8], b0[8], b1[8];
#pragma unroll
        for (int s = 0; s < 8; ++s) { const int ko = (hh * 8 + s) * 16; a[s] = *(const bf16x8v*)(ap + ko); b0[s] = *(const bf16x8v*)(b0p + ko); b1[s] = *(const bf16x8v*)(b1p + ko); }
#pragma unroll
        for (int s = 0; s < 8; ++s) { c0 = __builtin_amdgcn_mfma_f32_32x32x16_bf16(a[s], b0[s], c0, 0, 0, 0); c1 = __builtin_amdgcn_mfma_f32_32x32x16_bf16(a[s], b1[s], c1, 0, 0, 0); }
    }
    __syncthreads();
#pragma unroll
    for (int i = 0; i < 16; ++i) { const int row = (i & 3) + 8 * (i >> 2) + 4 * h; red[(F.wave * 32 + row) * 64 + r] = c0[i]; red[(F.wave * 32 + row) * 64 + 32 + r] = c1[i]; }
    __syncthreads();
    { const int e = F.tid * 4, row = e >> 6, col = e & 63; f32x4 sacc = {0.f, 0.f, 0.f, 0.f};
#pragma unroll
      for (int w = 0; w < 8; ++w) sacc += *(const LAS f32x4*)(red + (w * 32 + row) * 64 + col);
      v2u o; o.x = pk2(sacc[0], sacc[1]); o.y = pk2(sacc[2], sacc[3]);
      *(v2u*)(UCTX + (size_t)(tr * 32 + row) * 1024 + tc * 64 + col) = o; }
    __syncthreads();
}
__device__ __forceinline__ void pf3_final(Frame& F) {
    const int gw = F.bid * NWAVES + F.wave, NGW = F.G * NWAVES;
    const bf16* F2 = (const bf16*)(F.ws + WS_A);
    for (int r0 = gw; r0 < M; r0 += 2 * NGW) {
        f32x4 v[2][8];
#pragma unroll
        for (int q = 0; q < 2; ++q) { const int r = r0 + q * NGW; if (r >= M) continue;
#pragma unroll
            for (int j = 0; j < 8; ++j) { const int c = 4 * F.lane + 256 * j; v[q][j] = *(const f32x4*)(F.out + (size_t)r * D + c);
                const v2u f = *(const v2u*)(F2 + (size_t)r * D + c); v[q][j] += (f32x4){pg8::bf_lo(f.x), pg8::bf_hi(f.x), pg8::bf_lo(f.y), pg8::bf_hi(f.y)}; } }
#pragma unroll
        for (int q = 0; q < 2; ++q) { const int r = r0 + q * NGW; if (r >= M) continue;
            float ss = 0.f;
#pragma unroll
            for (int j = 0; j < 8; ++j) ss += (v[q][j][0] * v[q][j][0] + v[q][j][1] * v[q][j][1]) + (v[q][j][2] * v[q][j][2] + v[q][j][3] * v[q][j][3]);
            const float rstd = 1.0f / sqrtf(wave_sum(ss) * (1.0f / D) + EPS);
#pragma unroll
            for (int j = 0; j < 8; ++j) { const int c = 4 * F.lane + 256 * j; const f32x4 g = *(const f32x4*)(F.in[I_NF] + c); *(f32x4*)(F.out + (size_t)r * D + c) = v[q][j] * rstd * g; } }
    }
}
#define FFT_HD __device__ __forceinline__
#define FFT_AT(d, byteoff) (*(LAS cf*)((LAS char*)(d) + (byteoff)))
typedef float cf __attribute__((ext_vector_type(2)));
FFT_HD cf cmulf(cf a, cf b) { const cf t = a.xx * b; return a.yy * (b.yx * cf{-1.f, 1.f}) + t; }
FFT_HD cf cmulcf(cf a, cf b) { const cf t = a * b.xx; return a.yx * (b.yy * cf{1.f, -1.f}) + t; }
FFT_HD int fft_swz(int e) { return e ^ (((e >> 6) & 7) << 2) ^ (((e >> 5) & 1) << 1); }
template <int SGN> FFT_HD void dft4(cf& a, cf& b, cf& c, cf& d) {
    const cf s0 = a + c, d0 = a - c, s1 = b + d, d1 = b - d;
    const cf id1 = d1.yx * cf{-1.f, 1.f};
    a = s0 + s1; c = s0 - s1;
    if (SGN < 0) { b = d0 - id1; d = d0 + id1; } else { b = d0 + id1; d = d0 - id1; }
}
template <int SGN> FFT_HD void dft16(cf (&x)[16]) {
    constexpr float C1 = 0.92387953251128674f, S1 = 0.38268343236508977f, R2 = 0.70710678118654752f;
#pragma unroll
    for (int n2 = 0; n2 < 4; ++n2) dft4<SGN>(x[n2], x[4 + n2], x[8 + n2], x[12 + n2]);
    const float sg = (float)SGN;
#define TW(idx, cr, ci) { const cf w = {cr, sg * (ci)}; x[idx] = cmulf(x[idx], w); }
    TW(5, C1, S1) TW(6, R2, R2) TW(7, S1, C1)
    TW(9, R2, R2) { x[10] = x[10].yx * cf{-sg, sg}; } TW(11, -R2, R2)
    TW(13, S1, C1) TW(14, -R2, R2) TW(15, -C1, -S1)
#undef TW
#pragma unroll
    for (int k1 = 0; k1 < 4; ++k1) dft4<SGN>(x[4 * k1], x[4 * k1 + 1], x[4 * k1 + 2], x[4 * k1 + 3]);
#pragma unroll
    for (int a = 0; a < 4; ++a)
#pragma unroll
        for (int b = a + 1; b < 4; ++b) { const cf t = x[4 * a + b]; x[4 * a + b] = x[4 * b + a]; x[4 * b + a] = t; }
}
FFT_HD void cpowers16(cf w1, cf (&p)[16]) {
    p[0] = cf{1.f, 0.f}; p[1] = w1; p[2] = cmulf(w1, w1); p[3] = cmulf(p[2], w1); p[4] = cmulf(p[2], p[2]); p[5] = cmulf(p[4], w1); p[6] = cmulf(p[4], p[2]); p[7] = cmulf(p[4], p[3]);
    p[8] = cmulf(p[4], p[4]); p[9] = cmulf(p[8], w1); p[10] = cmulf(p[8], p[2]); p[11] = cmulf(p[8], p[3]); p[12] = cmulf(p[8], p[4]); p[13] = cmulf(p[8], p[5]); p[14] = cmulf(p[8], p[6]); p[15] = cmulf(p[8], p[7]);
}
template <bool CONJ> FFT_HD void twiddle16(cf (&x)[16], cf w1) {
    const cf p1 = CONJ ? cf{w1.x, -w1.y} : w1, p2 = cmulf(p1, p1), p3 = cmulf(p2, p1), p4 = cmulf(p2, p2), p5 = cmulf(p4, p1), p6 = cmulf(p4, p2), p7 = cmulf(p4, p3), p8 = cmulf(p4, p4);
    x[1] = cmulf(x[1], p1); x[2] = cmulf(x[2], p2); x[3] = cmulf(x[3], p3); x[4] = cmulf(x[4], p4); x[5] = cmulf(x[5], p5); x[6] = cmulf(x[6], p6); x[7] = cmulf(x[7], p7); x[8] = cmulf(x[8], p8);
    x[9] = cmulf(x[9], cmulf(p8, p1)); x[10] = cmulf(x[10], cmulf(p8, p2)); x[11] = cmulf(x[11], cmulf(p8, p3)); x[12] = cmulf(x[12], cmulf(p8, p4));
    x[13] = cmulf(x[13], cmulf(p8, p5)); x[14] = cmulf(x[14], cmulf(p8, p6)); x[15] = cmulf(x[15], cmulf(p8, p7));
}
template <int S> FFT_HD void pass16_offs(int q, int (&off)[16]) {
    if (S == 1024) { const int a0 = fft_swz(q) * 8;
#pragma unroll
        for (int m = 0; m < 16; ++m) off[m] = a0 + 8192 * m; }
    else if (S == 64) { const int B = q >> 6, j = q & 63, jj = j ^ (((j >> 5) & 1) << 1), A = (jj << 3) | (B << 13);
#pragma unroll
        for (int m = 0; m < 16; ++m) off[m] = (A ^ (32 * (m & 7))) + 512 * m; }
    else { const int b = q >> 2, j = q & 3, t = b & 7, P0 = (b << 9) | (t << 5) | (j << 3), P1 = (b << 9) | (t << 5) | ((j ^ 2) << 3) | 256;
#pragma unroll
        for (int m = 0; m < 16; ++m) off[m] = (m < 8 ? P0 : P1) ^ (32 * (m & 7)); }
}
#ifndef FFT_AT
#define FFT_AT(d, byteoff) (*(decltype(d))((char*)(d) + (byteoff)))
#endif
template <int S, class PT> FFT_HD void pass16_fwd(PT d, int q, cf w1) {
    int off[16]; pass16_offs<S>(q, off);
    cf x[16];
#pragma unroll
    for (int m = 0; m < 16; ++m) x[m] = FFT_AT(d, off[m]);
    dft16<-1>(x);
    twiddle16<false>(x, w1);
#pragma unroll
    for (int k = 0; k < 16; ++k) FFT_AT(d, off[k]) = x[k];
}
template <int S, class PT> FFT_HD void pass16_inv(PT d, int q, cf w1) {
    int off[16]; pass16_offs<S>(q, off);
    cf x[16];
#pragma unroll
    for (int k = 0; k < 16; ++k) x[k] = FFT_AT(d, off[k]);
    twiddle16<true>(x, w1);
    dft16<1>(x);
#pragma unroll
    for (int m = 0; m < 16; ++m) FFT_AT(d, off[m]) = x[m];
}
template <class PT> FFT_HD void pass4_fwd_load(PT d, int q, cf (&x)[4]) {
#pragma unroll
    for (int m = 0; m < 4; ++m) x[m] = d[fft_swz(4 * q + m)];
    dft4<-1>(x[0], x[1], x[2], x[3]);
}
template <class PT> FFT_HD void pass4_inv_store(PT d, int q, cf (&x)[4]) {
    dft4<1>(x[0], x[1], x[2], x[3]);
#pragma unroll
    for (int m = 0; m < 4; ++m) d[fft_swz(4 * q + m)] = x[m];
}

typedef LAS cf* ldscf;
typedef LAS f32x4* ldsf4;
struct FftTw { cf a, b, c, e; };
__device__ __forceinline__ FftTw fft_tw(const cf* W, int tid) { FftTw t; t.a = W[tid]; t.b = W[tid + 512]; t.c = W[16 * (tid & 63)]; t.e = W[256 * (tid & 3)]; return t; }
#define FFT_SEQ __builtin_amdgcn_sched_barrier(0)
__device__ __forceinline__ int opqi(int v) { asm volatile("" : "+v"(v)); return v; }
__device__ __forceinline__ cf opq(cf w) { asm volatile("" : "+v"(w.x), "+v"(w.y)); return w; }
__device__ __forceinline__ void fft_fwd2(ldscf d, int tid, const FftTw& t) {
    pass16_fwd<1024>(d, opqi(tid), opq(t.a)); FFT_SEQ; pass16_fwd<1024>(d, opqi(tid) + 512, opq(t.b)); __syncthreads();
    pass16_fwd<64>(d, opqi(tid), opq(t.c)); FFT_SEQ; pass16_fwd<64>(d, opqi(tid) + 512, opq(t.c)); __syncthreads();
}
__device__ __forceinline__ void fft_fwd_p3(ldscf d, int tid, const FftTw& t) {
    pass16_fwd<4>(d, opqi(tid), opq(t.e)); FFT_SEQ; pass16_fwd<4>(d, opqi(tid) + 512, opq(t.e)); __syncthreads();
}
__device__ __forceinline__ void fft_inv3(ldscf d, int tid, const FftTw& t) {
    pass16_inv<4>(d, opqi(tid), opq(t.e)); FFT_SEQ; pass16_inv<4>(d, opqi(tid) + 512, opq(t.e)); __syncthreads();
    pass16_inv<64>(d, opqi(tid), opq(t.c)); FFT_SEQ; pass16_inv<64>(d, opqi(tid) + 512, opq(t.c)); __syncthreads();
    pass16_inv<1024>(d, opqi(tid), opq(t.a)); FFT_SEQ; pass16_inv<1024>(d, opqi(tid) + 512, opq(t.b)); __syncthreads();
}
__device__ __forceinline__ int fft_pos_of_negf(int pos) {
    const int f = (pos >> 10) + 16 * ((pos >> 6) & 15) + 256 * ((pos >> 2) & 15) + 4096 * (pos & 3), g = (16384 - f) & 16383;
    return ((g & 15) << 10) | (((g >> 4) & 15) << 6) | (((g >> 8) & 15) << 2) | (g >> 12);
}
__device__ __forceinline__ void filter_fft(Frame& F, float* KS) {
    ldscf d = (ldscf)F.lds; const FftTw tw = fft_tw((const cf*)(F.ws + WS_TW), F.tid);
    for (int u = F.bid; u < HYW / 2; u += F.G) {
        float* ta = KS + (size_t)(2 * u) * 32768; float* tb = ta + 32768;
        f32x4 va[8], vb[8];
#pragma unroll
        for (int ci = 0; ci < 4; ++ci) { const int m0 = ci * 4096 + 8 * F.tid; va[2 * ci] = *(const f32x4*)(ta + m0); va[2 * ci + 1] = *(const f32x4*)(ta + m0 + 4); vb[2 * ci] = *(const f32x4*)(tb + m0); vb[2 * ci + 1] = *(const f32x4*)(tb + m0 + 4); }
        __syncthreads();
#pragma unroll
        for (int ci = 0; ci < 4; ++ci) { const int m0 = ci * 4096 + 8 * F.tid;
#pragma unroll
            for (int k = 0; k < 4; ++k) { const f32x4 a = va[2 * ci + (k >> 1)], b = vb[2 * ci + (k >> 1)]; const int o = (k & 1) * 2;
                *(ldsf4)(d + fft_swz(m0 + 2 * k)) = (f32x4){a[o], b[o], a[o + 1], b[o + 1]}; } }
        __syncthreads();
        fft_fwd2(d, F.tid, tw); fft_fwd_p3(d, F.tid, tw);
        for (int q = F.tid; q < 4096; q += NTHR) { cf r[4]; pass4_fwd_load(d, q, r);
#pragma unroll
            for (int m = 0; m < 4; ++m) d[fft_swz(4 * q + m)] = r[m]; }
        __syncthreads();
        cf* ka = (cf*)ta; cf* kb = (cf*)tb;
        for (int q = F.tid; q < 4096; q += NTHR) {
            f32x4 oa[2], ob[2];
#pragma unroll
            for (int m = 0; m < 4; ++m) { const int pos = 4 * q + m; const cf zf = d[fft_swz(pos)], zm = d[fft_swz(fft_pos_of_negf(pos))];
                const float s = 0.5f / 16384.0f;
                oa[m >> 1][(m & 1) * 2] = (zf.x + zm.x) * s; oa[m >> 1][(m & 1) * 2 + 1] = (zf.y - zm.y) * s;
                ob[m >> 1][(m & 1) * 2] = (zf.y + zm.y) * s; ob[m >> 1][(m & 1) * 2 + 1] = (zm.x - zf.x) * s; }
            *(f32x4*)(ka + 4 * q) = oa[0]; *(f32x4*)(ka + 4 * q + 2) = oa[1]; *(f32x4*)(kb + 4 * q) = ob[0]; *(f32x4*)(kb + 4 * q + 2) = ob[1]; }
    }
    __syncthreads();
}
__device__ __forceinline__ void sconv8(const v4u raw, float left, float right, float w0, float w1, float w2, float bb, float (&o)[8]) {
    float h[10]; h[0] = left; h[9] = right;
    h[1] = pg8::bf_lo(raw.x); h[2] = pg8::bf_hi(raw.x); h[3] = pg8::bf_lo(raw.y); h[4] = pg8::bf_hi(raw.y); h[5] = pg8::bf_lo(raw.z); h[6] = pg8::bf_hi(raw.z); h[7] = pg8::bf_lo(raw.w); h[8] = pg8::bf_hi(raw.w);
#pragma unroll
    for (int i = 0; i < 8; ++i) o[i] = h[i] * w0 + h[i + 1] * w1 + h[i + 2] * w2 + bb;
}
typedef unsigned short us2 __attribute__((ext_vector_type(2)));
struct Raw8 { v4u v; us2 lr; };
__device__ __forceinline__ Raw8 load_raw8(const bf16* row  , int t0) {
    Raw8 x; x.v = *(const v4u*)(row + t0); x.lr.x = row[t0 > 0 ? t0 - 1 : 0]; x.lr.y = row[t0 + 8 < SEQ ? t0 + 8 : t0]; return x;
}
__device__ __forceinline__ void sconv8r(const Raw8& x, int t0, float w0, float w1, float w2, float bb, float (&o)[8]) {
    sconv8(x.v, t0 > 0 ? __uint_as_float((unsigned)x.lr.x << 16) : 0.f, t0 + 8 < SEQ ? __uint_as_float((unsigned)x.lr.y << 16) : 0.f, w0, w1, w2, bb, o); }
#ifndef PROBE_T
#define PROBE_T -1
#endif
#define CSTAMP(i) do { if (PROBE_T >= 32 && F.bid == 0 && F.tid == 0 && c == 0) ((unsigned long long*)(F.ws + WS_TS))[32 + (i)] = __builtin_amdgcn_s_memrealtime(); } while (0)
__device__ __forceinline__ void conv_fft(Frame& F, const float* KS, bf16* CONVT) {
    ldscf d = (ldscf)F.lds; const FftTw tw = fft_tw((const cf*)(F.ws + WS_TW), F.tid);
    const bf16* HYT = (const bf16*)(F.ws + WS_HYT);
    const float* cw = F.in[I_CONVW]; const float* cb = F.in[I_CONVB];
    Raw8 ar[2][2], vr[2][2];
    if (F.bid < HYW) { const bf16* r1 = HYT + (size_t)(1024 + F.bid) * M; const bf16* r2 = HYT + (size_t)(2048 + F.bid) * M;
#pragma unroll
        for (int ci = 0; ci < 2; ++ci)
#pragma unroll
            for (int b = 0; b < 2; ++b) { ar[ci][b] = load_raw8(r1 + b * SEQ, ci * 4096 + 8 * F.tid); vr[ci][b] = load_raw8(r2 + b * SEQ, ci * 4096 + 8 * F.tid); } }
    for (int c = F.bid; c < HYW; c += F.G) {
        const int tid = opqi(F.tid);
        CSTAMP(0);
        const int c1 = 1024 + c, c2 = 2048 + c;
        const bf16* r0 = HYT + (size_t)c * M;
        const cf* ks = (const cf*)(KS + (size_t)c * 32768);
        const float hb = F.in[I_HBIAS][c];
        float w[2][2][8];
        { const float a0 = cw[c1], a1 = cw[3072 + c1], a2 = cw[6144 + c1], ab = cb[c1], v0 = cw[c2], v1 = cw[3072 + c2], v2 = cw[6144 + c2], vb = cb[c2];
#pragma unroll
          for (int ci = 0; ci < 2; ++ci)
#pragma unroll
            for (int b = 0; b < 2; ++b) { float xa[8], xv[8]; sconv8r(ar[ci][b], ci * 4096 + 8 * tid, a0, a1, a2, ab, xa); sconv8r(vr[ci][b], ci * 4096 + 8 * tid, v0, v1, v2, vb, xv);
#pragma unroll
                for (int i = 0; i < 8; ++i) w[ci][b][i] = xa[i] * xv[i]; } }
        __syncthreads();
#pragma unroll
        for (int ci = 0; ci < 2; ++ci) { const int t0 = ci * 4096 + 8 * tid;
#pragma unroll
            for (int k = 0; k < 4; ++k) { *(ldsf4)(d + fft_swz(t0 + 2 * k)) = (f32x4){w[ci][0][2 * k], w[ci][1][2 * k], w[ci][0][2 * k + 1], w[ci][1][2 * k + 1]};
                *(ldsf4)(d + fft_swz(SEQ + t0 + 2 * k)) = (f32x4){0.f, 0.f, 0.f, 0.f}; } }
        f32x4 kreg[16];
#pragma unroll
        for (int i = 0; i < 8; ++i) { const int q = tid + 512 * i; kreg[2 * i] = *(const f32x4*)(ks + 4 * q); kreg[2 * i + 1] = *(const f32x4*)(ks + 4 * q + 2); }
        __syncthreads();
        CSTAMP(1);
        fft_fwd2(d, tid, tw);
        CSTAMP(2);
        fft_fwd_p3(d, tid, tw);
        CSTAMP(3);
#pragma unroll
        for (int i = 0; i < 8; ++i) { const int q = opqi(tid) + 512 * i; cf r[4]; pass4_fwd_load(d, q, r);
            const f32x4 k0 = kreg[2 * i], k1 = kreg[2 * i + 1];
            r[0] = cmulf(r[0], cf{k0[0], k0[1]}); r[1] = cmulf(r[1], cf{k0[2], k0[3]}); r[2] = cmulf(r[2], cf{k1[0], k1[1]}); r[3] = cmulf(r[3], cf{k1[2], k1[3]});
            pass4_inv_store(d, q, r); }
        __syncthreads();
        CSTAMP(4);
        pass16_inv<4>(d, opqi(tid), opq(tw.e)); FFT_SEQ; pass16_inv<4>(d, opqi(tid) + 512, opq(tw.e)); __syncthreads();
        if (c + F.G < HYW) { const bf16* n1 = HYT + (size_t)(1024 + c + F.G) * M; const bf16* n2 = HYT + (size_t)(2048 + c + F.G) * M;
#pragma unroll
            for (int ci = 0; ci < 2; ++ci)
#pragma unroll
                for (int b = 0; b < 2; ++b) { ar[ci][b] = load_raw8(n1 + b * SEQ, ci * 4096 + 8 * tid); vr[ci][b] = load_raw8(n2 + b * SEQ, ci * 4096 + 8 * tid); } }
        pass16_inv<64>(d, opqi(tid), opq(tw.c)); FFT_SEQ; pass16_inv<64>(d, opqi(tid) + 512, opq(tw.c)); __syncthreads();
        Raw8 xr[2][2];
#pragma unroll
        for (int ci = 0; ci < 2; ++ci)
#pragma unroll
            for (int b = 0; b < 2; ++b) xr[ci][b] = load_raw8(r0 + b * SEQ, ci * 4096 + 8 * tid);
        pass16_inv<1024>(d, opqi(tid), opq(tw.a)); FFT_SEQ; pass16_inv<1024>(d, opqi(tid) + 512, opq(tw.b)); __syncthreads();
        CSTAMP(5);
        { const float x0w0 = cw[c], x0w1 = cw[3072 + c], x0w2 = cw[6144 + c], x0b = cb[c];
#pragma unroll
          for (int ci = 0; ci < 2; ++ci) { const int t0 = ci * 4096 + 8 * tid;
            float y[2][8];
#pragma unroll
            for (int k = 0; k < 4; ++k) { const f32x4 q = *(ldsf4)(d + fft_swz(t0 + 2 * k)); y[0][2 * k] = q[0]; y[1][2 * k] = q[1]; y[0][2 * k + 1] = q[2]; y[1][2 * k + 1] = q[3]; }
#pragma unroll
            for (int b = 0; b < 2; ++b) { float x0[8]; sconv8r(xr[ci][b], t0, x0w0, x0w1, x0w2, x0b, x0);
                float o[8];
#pragma unroll
                for (int i = 0; i < 8; ++i) o[i] = x0[i] * (y[b][i] + hb * w[ci][b][i]);
                v4u pk; pk.x = pk2(o[0], o[1]); pk.y = pk2(o[2], o[3]); pk.z = pk2(o[4], o[5]); pk.w = pk2(o[6], o[7]);
                *(v4u*)(CONVT + (size_t)c * M + b * SEQ + t0) = pk; } } }
        CSTAMP(6);
    }
    __syncthreads();
}
__device__ __forceinline__ void transpose_conv(Frame& F, const bf16* CONVT, bf16* HYB) {
    LAS bf16* tl = (LAS bf16*)(F.lds + F.wave * 8704);
    const int gw = F.bid * NWAVES + F.wave, NGW = F.G * NWAVES;
    for (int it = gw; it < 16 * 256; it += NGW) {
        const int cb = it & 15, tb = it >> 4, c0 = cb * 64, t0 = tb * 64;
#pragma unroll
        for (int i = 0; i < 8; ++i) { const int ch = i * 8 + (F.lane >> 3), tk = (F.lane & 7) * 8;
            const v4u v = *(const v4u*)(CONVT + (size_t)(c0 + ch) * M + t0 + tk);
            LAS unsigned* p = (LAS unsigned*)(tl + ch * 66 + tk); p[0] = v.x; p[1] = v.y; p[2] = v.z; p[3] = v.w; }
        LDS_WAIT(); asm volatile("" ::: "memory");
#pragma unroll
        for (int i = 0; i < 8; ++i) { const int tk = i * 8 + (F.lane >> 3), ch = (F.lane & 7) * 8;
            unsigned short e[8];
#pragma unroll
            for (int k = 0; k < 8; ++k) e[k] = tl[(ch + k) * 66 + tk];
            v4u o; o.x = e[0] | ((unsigned)e[1] << 16); o.y = e[2] | ((unsigned)e[3] << 16); o.z = e[4] | ((unsigned)e[5] << 16); o.w = e[6] | ((unsigned)e[7] << 16);
            *(v4u*)(HYB + (size_t)(t0 + tk) * HYW + c0 + ch) = o; }
        LDS_WAIT(); asm volatile("" ::: "memory");
    }
}
__device__ __forceinline__ void s5_kd_gen(Frame& F) {
    const float2* LAMB = (const float2*)(F.ws + WS_LAMB); const float2* BBAR = (const float2*)(F.ws + WS_BBAR); float* KD = (float*)(F.ws + WS_KD);
    LAS float* red = (LAS float*)F.lds;
    for (int task = F.bid; task < 128; task += F.G) {
        const int g = task >> 1, d = task & 1, ph = F.tid >> 8, h = (F.tid >> 4) & 15, hp = F.tid & 15, dg = d * 64 + g;
        float acc[16];
#pragma unroll
        for (int k = 0; k < 16; ++k) acc[k] = 0.f;
#pragma unroll 4
        for (int pi = 0; pi < 32; ++pi) { const int p = ph * 32 + pi;
            const float2 lam = LAMB[dg * 64 + p], bb = BBAR[(size_t)(dg * 64 + p) * 16 + hp];
            const float cr = F.in[I_CRE][(size_t)(dg * 16 + h) * 64 + p], ci = F.in[I_CIM][(size_t)(dg * 16 + h) * 64 + p];
            float qr = cr * bb.x - ci * bb.y, qi = cr * bb.y + ci * bb.x;
#pragma unroll
            for (int k = 0; k < 16; ++k) { acc[k] += qr; const float nr = qr * lam.x - qi * lam.y, ni = qr * lam.y + qi * lam.x; qr = nr; qi = ni; }
        }
        __syncthreads();
        if (ph == 1) {
#pragma unroll
            for (int k = 0; k < 16; ++k) red[k * 256 + (F.tid & 255)] = acc[k]; }
        __syncthreads();
        if (ph == 0) {
#pragma unroll
            for (int k = 0; k < 16; ++k) KD[((size_t)(g * 2 + d) * 16 + k) * 256 + h * 16 + hp] = acc[k] + red[k * 256 + F.tid]; }
    }
    __syncthreads();
}
__device__ __forceinline__ void s5_w1t_gen(Frame& F) {
    const float2* LAMB = (const float2*)(F.ws + WS_LAMB); const float2* BBAR = (const float2*)(F.ws + WS_BBAR); bf16* W1T = (bf16*)(F.ws + WS_W1T);
    const int gw = F.bid * NWAVES + F.wave, NGW = F.G * NWAVES;
    for (int it = gw; it < 64 * 256; it += NGW) {
        const int g = it >> 8, n = it & 255, d = n >> 7, p = (n & 127) >> 1, ri = n & 1, j = F.lane >> 2, h4 = (F.lane & 3) * 4, dgp = (d * 64 + g) * 64 + p;
        const float2 lam = LAMB[dgp]; const int pw = d ? j : 15 - j;
        float pr = 1.f, pi = 0.f;
        for (int k = 0; k < pw; ++k) { const float nr = pr * lam.x - pi * lam.y, ni = pr * lam.y + pi * lam.x; pr = nr; pi = ni; }
        float o[4];
#pragma unroll
        for (int e = 0; e < 4; ++e) { const float2 bb = BBAR[(size_t)dgp * 16 + h4 + e]; o[e] = ri ? (pr * bb.y + pi * bb.x) : (pr * bb.x - pi * bb.y); }
        v2u w; w.x = pk2(o[0], o[1]); w.y = pk2(o[2], o[3]);
        *(v2u*)(W1T + ((size_t)(g * 256 + n)) * 256 + j * 16 + h4) = w;
    }
}
__device__ __forceinline__ void s5_bt2_gen(Frame& F) {
    const float2* LAMB = (const float2*)(F.ws + WS_LAMB); const float* KD = (const float*)(F.ws + WS_KD); bf16* BT2 = (bf16*)(F.ws + WS_BT2);
    const int gw = F.bid * NWAVES + F.wave, NGW = F.G * NWAVES;
    for (int it = gw; it < 64 * 16; it += NGW) {
        const int g = it >> 4, h = it & 15, k0 = F.lane * 8;
        if (k0 < 256) { const int d = k0 >> 7, p0 = (k0 & 127) >> 1, dg = d * 64 + g;
            float2 lam[4]; float pr[4], pi[4];
#pragma unroll
            for (int e = 0; e < 4; ++e) { lam[e] = LAMB[dg * 64 + p0 + e]; pr[e] = F.in[I_CRE][(size_t)(dg * 16 + h) * 64 + p0 + e]; pi[e] = F.in[I_CIM][(size_t)(dg * 16 + h) * 64 + p0 + e]; }
#pragma unroll 4
            for (int s = 0; s < 16; ++s) { const int i = d ? 15 - s : s;
                float o[8];
#pragma unroll
                for (int e = 0; e < 4; ++e) { const float nr = pr[e] * lam[e].x - pi[e] * lam[e].y, ni = pr[e] * lam[e].y + pi[e] * lam[e].x; pr[e] = nr; pi[e] = ni; o[2 * e] = nr; o[2 * e + 1] = -ni; }
                v4u w; w.x = pk2(o[0], o[1]); w.y = pk2(o[2], o[3]); w.z = pk2(o[4], o[5]); w.w = pk2(o[6], o[7]);
                *(v4u*)(BT2 + ((size_t)(g * 256 + i * 16 + h)) * 512 + k0) = w; }
        } else { const int kk = k0 - 256, j = kk >> 4, hp0 = kk & 15;
#pragma unroll 4
            for (int i = 0; i < 16; ++i) {
                const float* kf = KD + ((size_t)(g * 2 + 0) * 16 + (i >= j ? i - j : 0)) * 256 + h * 16 + hp0;
                const float* kb = KD + ((size_t)(g * 2 + 1) * 16 + (j >= i ? j - i : 0)) * 256 + h * 16 + hp0;
                const f32x4 f0 = *(const f32x4*)kf, f1 = *(const f32x4*)(kf + 4), b0 = *(const f32x4*)kb, b1 = *(const f32x4*)(kb + 4);
                const float sf = i >= j ? 1.f : 0.f, sb = j >= i ? 1.f : 0.f;
                const f32x4 o0 = f0 * sf + b0 * sb, o1 = f1 * sf + b1 * sb;
                v4u w; w.x = pk2(o0[0], o0[1]); w.y = pk2(o0[2], o0[3]); w.z = pk2(o1[0], o1[1]); w.w = pk2(o1[2], o1[3]);
                *(v4u*)(BT2 + ((size_t)(g * 256 + i * 16 + h)) * 512 + k0) = w; } }
    }
}
__device__ __forceinline__ void s5_ctx_states(Frame& F) {
    LAS cf* part = (LAS cf*)F.lds;
    const bf16* UCTX = (const bf16*)(F.ws + WS_UCTX);
    for (int unit = F.bid; unit < 256; unit += F.G) {
        const int b = unit >> 7, d = (unit >> 6) & 1, g = unit & 63, p = F.lane, dgp = (d * 64 + g) * 64 + p;
        const float2 lam = ((const float2*)(F.ws + WS_LAMB))[dgp];
        const float2* BB = (const float2*)(F.ws + WS_BBAR) + (size_t)dgp * 16;
        float2 Bb[16];
#pragma unroll
        for (int h = 0; h < 16; ++h) Bb[h] = BB[h];
        float sr = 0.f, si = 0.f;
#pragma unroll 1
        for (int s0 = 0; s0 < 32; s0 += 8) {
            v4u ua[8], ub[8];
#pragma unroll
            for (int s = 0; s < 8; ++s) { const int step = F.wave * 32 + s0 + s, tc = d == 0 ? step : (CTX - 1 - step); const bf16* up = UCTX + (size_t)(b * CTX + tc) * 1024 + g * 16; ua[s] = *(const v4u*)up; ub[s] = *(const v4u*)(up + 8); }
#pragma unroll
            for (int s = 0; s < 8; ++s) { const v4u u0 = ua[s], u1 = ub[s];
                float uu[16];
                uu[0] = pg8::bf_lo(u0.x); uu[1] = pg8::bf_hi(u0.x); uu[2] = pg8::bf_lo(u0.y); uu[3] = pg8::bf_hi(u0.y); uu[4] = pg8::bf_lo(u0.z); uu[5] = pg8::bf_hi(u0.z); uu[6] = pg8::bf_lo(u0.w); uu[7] = pg8::bf_hi(u0.w);
                uu[8] = pg8::bf_lo(u1.x); uu[9] = pg8::bf_hi(u1.x); uu[10] = pg8::bf_lo(u1.y); uu[11] = pg8::bf_hi(u1.y); uu[12] = pg8::bf_lo(u1.z); uu[13] = pg8::bf_hi(u1.z); uu[14] = pg8::bf_lo(u1.w); uu[15] = pg8::bf_hi(u1.w);
                float br = 0.f, bi = 0.f;
#pragma unroll
                for (int h = 0; h < 16; ++h) { br += Bb[h].x * uu[h]; bi += Bb[h].y * uu[h]; }
                const float nr = lam.x * sr - lam.y * si + br, ni = lam.x * si + lam.y * sr + bi; sr = nr; si = ni; } }
        __syncthreads();
        part[F.wave * 64 + p] = cf{sr, si};
        __syncthreads();
        if (F.wave == 0) { const float2 l32 = ((const float2*)(F.ws + WS_LAM32))[dgp]; float ar = 0.f, ai = 0.f;
#pragma unroll
            for (int w = 0; w < 8; ++w) { const cf q = part[w * 64 + p]; const float nr = l32.x * ar - l32.y * ai + q.x, ni = l32.x * ai + l32.y * ar + q.y; ar = nr; ai = ni; }
            ((float2*)(F.ws + WS_CTXS))[(size_t)(b * 2 + d) * 4096 + g * 64 + p] = make_float2(ar, ai); }
    }
    __syncthreads();
}
__device__ __forceinline__ void s5_carry(Frame& F) {
    LAS cf* ex = (LAS cf*)F.lds;
    const float* SL = (const float*)(F.ws + WS_SLOC); bf16* A2 = (bf16*)(F.ws + WS_A2);
    for (int unit = F.bid; unit < 256; unit += F.G) {
        const int b = unit >> 7, d = (unit >> 6) & 1, g = unit & 63, p = F.lane, dgp = (d * 64 + g) * 64 + p;
        const float2 l16 = ((const float2*)(F.ws + WS_LAM16))[dgp], l1024 = ((const float2*)(F.ws + WS_LAM1024))[dgp];
        const size_t rowbase = (size_t)g * 1024 + b * 512;
        float sr = 0.f, si = 0.f;
#pragma unroll 1
        for (int hb = 0; hb < 4; ++hb) {
            float2 v[16];
#pragma unroll
            for (int i = 0; i < 16; ++i) { const int cs = F.wave * 64 + hb * 16 + i, c = d == 0 ? cs : 511 - cs; v[i] = *(const float2*)(SL + (rowbase + c) * 256 + d * 128 + 2 * p); }
#pragma unroll
            for (int i = 0; i < 16; ++i) { const float nr = l16.x * sr - l16.y * si + v[i].x, ni = l16.x * si + l16.y * sr + v[i].y; sr = nr; si = ni; }
        }
        __syncthreads();
        ex[F.wave * 64 + p] = cf{sr, si};
        __syncthreads();
        const float2 init = ((const float2*)(F.ws + WS_CTXS))[(size_t)(b * 2 + d) * 4096 + g * 64 + p];
        float ar = init.x, ai = init.y;
        for (int w = 0; w < F.wave; ++w) { const cf e = ex[w * 64 + p]; const float nr = l1024.x * ar - l1024.y * ai + e.x, ni = l1024.x * ai + l1024.y * ar + e.y; ar = nr; ai = ni; }
#pragma unroll 1
        for (int hb = 0; hb < 4; ++hb) {
            float2 v[16];
#pragma unroll
            for (int i = 0; i < 16; ++i) { const int cs = F.wave * 64 + hb * 16 + i, c = d == 0 ? cs : 511 - cs; v[i] = *(const float2*)(SL + (rowbase + c) * 256 + d * 128 + 2 * p); }
#pragma unroll
            for (int i = 0; i < 16; ++i) { const int cs = F.wave * 64 + hb * 16 + i, c = d == 0 ? cs : 511 - cs;
                *(unsigned*)(A2 + (rowbase + c) * 512 + d * 128 + 2 * p) = pk2(ar, ai);
                const float nr = l16.x * ar - l16.y * ai + v[i].x, ni = l16.x * ai + l16.y * ar + v[i].y; ar = nr; ai = ni; }
        }
    }
    __syncthreads();
}
#ifndef PROBE_DUP
#define PROBE_DUP 0
#endif
#define REP(bit) for (int rep_ = 0; rep_ < 1 + ((PROBE_DUP >> (bit)) & 1); ++rep_)
#ifndef PROBE_SKEW
#define PROBE_SKEW -1
#endif
#ifndef PROBE_T
#define PROBE_T -1
#endif
#ifndef PROBE_SCALE
#define PROBE_SCALE 0.001f
#endif
#ifndef N_PHASES
#define N_PHASES 13
#endif
__device__ __forceinline__ bool fresh(Frame& F) { int t = F.tid; asm volatile("" : "+v"(t)); F.tid = t; F.lane = t & 63; return true; }
__global__ void __launch_bounds__(NTHR, 2) mega(Args args) {
    extern __shared__ __attribute__((aligned(16))) unsigned char lds_raw[];
    Frame F;
    F.lds = (LAS unsigned char*)lds_raw;
    F.tid = threadIdx.x; F.lane = F.tid & 63; F.wave = __builtin_amdgcn_readfirstlane(F.tid >> 6);
    F.bid = blockIdx.x; F.G = gridDim.x;
#pragma unroll
    for (int i = 0; i < 34; ++i) F.in[i] = args.in[i];
    F.out = args.out; F.ws = args.ws;
    const int lo = args.ph_lo, hi = args.ph_hi;
    cg::grid_group grid = cg::this_grid();
    volatile LAS unsigned* bst = (volatile LAS unsigned*)(F.lds + LDS_BYTES - 16);
    if (F.tid < 2) bst[F.tid] = 0u;
    __syncthreads();
    XcdBarrier bar; bar.bar = (unsigned*)(F.ws + WS_BAR); bar.x = 0; bar.st = bst;
#define IN(k) (lo <= (k) && (k) < hi && fresh(F))
#define STAMP(k) do { if (PROBE_T >= 0 && F.bid == 0 && F.tid == 0) ((unsigned long long*)(F.ws + WS_TS))[k] = __builtin_amdgcn_s_memrealtime(); } while (0)
    STAMP(0);
#define SEAM(k) do { if (PROBE_SKEW == (k) && F.tid == 0) ((unsigned long long*)(F.ws + WS_TS))[64 + F.bid] = __builtin_amdgcn_s_memrealtime(); if (lo <= (k) && (k) + 1 < hi) { if ((k) == 0) { grid.sync(); bar = xcd_barrier_post((unsigned*)(F.ws + WS_BAR), bst); } else xcd_barrier(bar); } STAMP((k) + 1); } while (0)
    unsigned char* ws = F.ws;
    typedef pg8::bf16_t pb;
    if (IN(0)) { p0_prologue(F); } SEAM(0);
    if (IN(1)) {
        ada_reduce(F);
        { pg8::Gemm g{(const pb*)(ws + WS_F3WT), (const pb*)(ws + WS_H2B), 2048, 8192, 256}; pg8::StaticOrder S; S.init(2048, 8192, F.G, F.bid);
          pg8::EpiTaps E{F.out, F.in[I_DECAY]}; pg8::gemm_phase<pg8::EpiTaps, pg8::StaticOrder, true, true>(F.lds, g, S, E); }
        __syncthreads();
        s5_kd_gen(F); s5_w1t_gen(F);
    } SEAM(1);
    if (IN(2)) {
        if (PROBE_T >= 40 && F.bid == 0 && F.tid == 0) ((unsigned long long*)(F.ws + WS_TS))[40] = __builtin_amdgcn_s_memrealtime();
        p1_modulate(F); __syncthreads();
        if (PROBE_T >= 40 && F.bid == 0 && F.tid == 0) ((unsigned long long*)(F.ws + WS_TS))[41] = __builtin_amdgcn_s_memrealtime();
        filter_fft(F, F.out);
        if (PROBE_T >= 40 && F.bid == 0 && F.tid == 0) ((unsigned long long*)(F.ws + WS_TS))[42] = __builtin_amdgcn_s_memrealtime();
        ffn_fold_tables(F); __syncthreads();
        if (PROBE_T >= 40 && F.bid == 0 && F.tid == 0) ((unsigned long long*)(F.ws + WS_TS))[43] = __builtin_amdgcn_s_memrealtime();
        s5_bt2_gen(F); __syncthreads();
        if (PROBE_T >= 40 && F.bid == 0 && F.tid == 0) ((unsigned long long*)(F.ws + WS_TS))[44] = __builtin_amdgcn_s_memrealtime();
    } SEAM(2);
    if (IN(3)) {
        ctx_gemm_small(F);
        { pg8::Gemm g{(const pb*)(ws + WS_A), (const pb*)(ws + WS_WIN), M, S5W, D}; pg8::StaticOrder S; S.init(M, S5W, F.G, F.bid);
          pg8::EpiU E{(pb*)(ws + WS_A2), (pb*)(ws + WS_UCTX)}; pg8::gemm_phase<pg8::EpiU, pg8::StaticOrder, true, true>(F.lds, g, S, E); }
        { pg8::Gemm g{(const pb*)(ws + WS_WIN) + (size_t)S5W * D, (const pb*)(ws + WS_A), 3 * HYW, M, D}; pg8::StaticOrder S; S.init(3 * HYW, M, F.G, F.bid);
          pg8::EpiStoreBf16 E{(pb*)(ws + WS_HYT), M}; pg8::gemm_phase<pg8::EpiStoreBf16, pg8::StaticOrder, true, true>(F.lds, g, S, E); }
        { pg8::Gemm g{(const pb*)(ws + WS_A), (const pb*)(ws + WS_WIN) + (size_t)(S5W + 3 * HYW) * D, M, 2 * D, D}; pg8::StaticOrder S; S.init(M, 2 * D, F.G, F.bid);
          pg8::EpiStoreBf16 E{(pb*)(ws + WS_GATES), 2 * D}; pg8::gemm_phase<pg8::EpiStoreBf16, pg8::StaticOrder, true, true>(F.lds, g, S, E); }
    } SEAM(3);
    if (IN(4)) {
        s5_ctx_states(F);
        { pg8::Gemm g{(const pb*)(ws + WS_A2) + 256, (const pb*)(ws + WS_W1T), 65536, 16384, 256, 512, 256}; pg8::BlockDiagOrder S{F.bid};
          pg8::EpiSloc E{(float*)(ws + WS_SLOC)}; pg8::gemm_phase<pg8::EpiSloc, pg8::BlockDiagOrder, true, true>(F.lds, g, S, E); }
        __syncthreads();
        asm volatile("" : "+v"(F.tid)); F.lane = F.tid & 63;
        conv_fft(F, F.out, (bf16*)(ws + WS_CONVT));
    } SEAM(4);
    if (IN(5)) { s5_carry(F); transpose_conv(F, (const bf16*)(ws + WS_CONVT), (bf16*)(ws + WS_HYB)); } SEAM(5);
    if (IN(6)) {
        { pg8::Gemm g{(const pb*)(ws + WS_A2), (const pb*)(ws + WS_BT2), 65536, 16384, 512, 512, 512}; pg8::BlockDiagOrder S{F.bid};
          pg8::EpiYg E{(pb*)(ws + WS_YG), (const pb*)(ws + WS_A2), F.in[I_S5D]}; pg8::gemm_phase<pg8::EpiYg, pg8::BlockDiagOrder, true, true>(F.lds, g, S, E); }
        { pg8::Gemm g{(const pb*)(ws + WS_HYB), (const pb*)(ws + WS_WHY), M, D, HYW}; pg8::StaticOrder S; S.init(M, D, F.G, F.bid);
          pg8::EpiHyOut E{(pb*)(ws + WS_A), (const pb*)(ws + WS_GATES)}; pg8::gemm_phase<pg8::EpiHyOut, pg8::StaticOrder, true, true>(F.lds, g, S, E); }
    } SEAM(6);
    if (IN(7)) {
        { pg8::Gemm g{(const pb*)(ws + WS_YG), (const pb*)(ws + WS_WGLU), M, 2 * D, S5W}; pg8::StaticOrder S; S.init(M, 2 * D, F.G, F.bid);
        pg8::EpiGlu E{(pb*)(ws + WS_MERGED), (const pb*)(ws + WS_GATES), (const pb*)(ws + WS_A)}; pg8::gemm_phase<pg8::EpiGlu, pg8::StaticOrder, true, true>(F.lds, g, S, E); }
    } SEAM(7);
    if (IN(8)) {
        pg8::Gemm g{(const pb*)(ws + WS_MERGED), (const pb*)(ws + WS_WOUT), M, D, D}; pg8::StaticOrder S; S.init(M, D, F.G, F.bid);
        pg8::EpiRes1 E{F.in[I_X], F.out, (const float*)(ws + WS_ADA) + 2 * D, NADA, (const float*)(ws + WS_TR), (const float*)(ws + WS_TC), (float*)(ws + WS_RSQ1), (pb*)(ws + WS_A), (const float*)(ws + WS_GAM)};
        pg8::gemm_phase<pg8::EpiRes1, pg8::StaticOrder, true, true>(F.lds, g, S, E);
    } SEAM(8);
    if (IN(9)) {
        pg8::Gemm g{(const pb*)(ws + WS_A), (const pb*)(ws + WS_WF1), M, 2 * DFF, D}; pg8::StaticOrder S; S.init(M, 2 * DFF, F.G, F.bid);
        { pg8::EpiSwiglu E{(pb*)(ws + WS_GATES), (const float*)(ws + WS_RSQ1), (const float*)(ws + WS_SW)}; pg8::gemm_phase<pg8::EpiSwiglu, pg8::StaticOrder, true, true>(F.lds, g, S, E); }
    } SEAM(9);
    if (IN(10)) {
        pg8::Gemm g{(const pb*)(ws + WS_GATES), (const pb*)(ws + WS_WF2), M, D, DFF}; pg8::StaticOrder S; S.init(M, D, F.G, F.bid);
        pg8::EpiGateBf16 E{(pb*)(ws + WS_A), (const float*)(ws + WS_ADA) + 5 * D, NADA};
        pg8::gemm_phase<pg8::EpiGateBf16, pg8::StaticOrder, true, true>(F.lds, g, S, E);
    } SEAM(10);
    if (IN(11)) { pf3_final(F); }
    if (PROBE_SKEW >= 0 && F.bid == 0) { __syncthreads(); if (F.tid < 64) { const unsigned long long* ts = (const unsigned long long*)(F.ws + WS_TS) + 64; unsigned long long mx = 0, mn = ~0ull;
        for (int i = F.tid; i < 256; i += 64) { const unsigned long long v = __hip_atomic_load(ts + i, __ATOMIC_RELAXED, __HIP_MEMORY_SCOPE_AGENT); mx = v > mx ? v : mx; mn = v < mn ? v : mn; }
        for (int o = 1; o < 64; o <<= 1) { const unsigned long long a = __shfl_xor(mx, o), b2 = __shfl_xor(mn, o); mx = a > mx ? a : mx; mn = b2 < mn ? b2 : mn; }
        F.out[F.tid] += (float)(mx - mn) * 0.01f * PROBE_SCALE; } }
    if (PROBE_T >= 0 && F.bid == 0) { STAMP(12); __syncthreads(); if (F.tid < 64) { const unsigned long long* ts = (const unsigned long long*)(F.ws + WS_TS); asm volatile("s_waitcnt vmcnt(0)" ::: "memory");
        const float us = (float)(__hip_atomic_load(ts + PROBE_T + 1, __ATOMIC_RELAXED, __HIP_MEMORY_SCOPE_AGENT) - __hip_atomic_load(ts + PROBE_T, __ATOMIC_RELAXED, __HIP_MEMORY_SCOPE_AGENT)) * 0.01f; F.out[F.tid] += us * PROBE_SCALE; } }
#undef IN
#undef SEAM
}

#ifndef MK_ONE_LAUNCH
#define MK_ONE_LAUNCH 1
#endif
extern "C" void kernel_launch(void* const* d_in, const int* in_sizes, int n_in, void* d_out, int out_size, void* d_ws, size_t ws_size, hipStream_t stream) {
    static int grid = 0;
    if (grid == 0) {
        if (n_in != 34 || out_size != M * D || ws_size < WS_END) { fprintf(stderr, "kernel_launch: unexpected shapes n_in %d out %d ws %zu\n", n_in, out_size, ws_size); grid = -1; return; }
        int dev = 0, cus = 0, per_cu = 0;
        (void)hipGetDevice(&dev); (void)hipDeviceGetAttribute(&cus, hipDeviceAttributeMultiprocessorCount, dev);
        (void)hipFuncSetAttribute((const void*)mega, hipFuncAttributeMaxDynamicSharedMemorySize, LDS_BYTES);
        (void)hipOccupancyMaxActiveBlocksPerMultiprocessor(&per_cu, (const void*)mega, NTHR, LDS_BYTES);
        (void)hipGetLastError();
        grid = cus * (per_cu >= 1 ? 1 : 0);
        if (grid != 256) fprintf(stderr, "kernel_launch: grid %d (cus %d per_cu %d)\n", grid, cus, per_cu);
        if (grid <= 0) { grid = -1; return; }
    }
    if (grid < 0) return;
    Args a{};
    for (int i = 0; i < 34; ++i) a.in[i] = (const float*)d_in[i];
    a.out = (float*)d_out; a.ws = (unsigned char*)d_ws;
#if MK_ONE_LAUNCH
    a.ph_lo = 0; a.ph_hi = 12;
    void* kargs[] = {&a};
    hipError_t e = hipLaunchCooperativeKernel((const void*)mega, dim3(grid), dim3(NTHR), kargs, LDS_BYTES, stream);
    if (e != hipSuccess) fprintf(stderr, "cooperative launch failed: %s (grid %d)\n", hipGetErrorString(e), grid);
#else
    for (int ph = 0; ph < 12; ++ph) { a.ph_lo = ph; a.ph_hi = ph + 1; hipLaunchKernelGGL(mega, dim3(grid), dim3(NTHR), LDS_BYTES, stream, a); }
#endif
}
```
